# Optimizing an MI355X kernel written in HIP

```python
import jax, jax.numpy as jnp
from jax import lax
import numpy as np

D_MODEL = 1024
BATCH = 16
SEQ = 4096
DEPTH = 4

GRID_W = 64
N_EVEN = (DEPTH + 1) // 2
N_ODD = DEPTH // 2
REC_HEAD_DIM = 128
A_WIDTH = D_MODEL // 2
A_HEADS = A_WIDTH // REC_HEAD_DIM
A_DK = REC_HEAD_DIM
A_KEY = A_HEADS * A_DK
B_WIDTH = D_MODEL - A_WIDTH
B_HEADS = B_WIDTH // REC_HEAD_DIM
B_DH = REC_HEAD_DIM
MIX_WIDTH = A_WIDTH + B_WIDTH
_IN_SIZES = (A_KEY, A_KEY, A_KEY, A_WIDTH, A_WIDTH,
             B_WIDTH, B_WIDTH, B_WIDTH, B_WIDTH, 4 * B_HEADS)
IN_COLS = 3 * A_KEY + 2 * A_WIDTH + 4 * B_WIDTH + 4 * B_HEADS
CHUNK = 64
CONV_W = 5
NA_DH = 32
NA_HEADS = D_MODEL // NA_DH
WIN_R = 8
WIN_C = 16
COL_BLOCK = 16
COL_BAND = COL_BLOCK + WIN_C
FFN_HIDDEN = -(-8 * D_MODEL // (3 * 256)) * 256
ALPHA = (2.0 * DEPTH) ** 0.25
BETA = (8.0 * DEPTH) ** -0.25
LN_EPS = 1e-5
GN_EPS = 1e-6
NEG_BIG = -1e30
LB_FLOOR = 1e-30

kernel_name = "hgrn2_mlstm_natten_hybrid_encoder"


def _heads(t, n_heads):
    b, s, _ = t.shape
    return t.reshape(b, s, n_heads, -1).transpose(0, 2, 1, 3)


def _merge(t):
    b, n, s, d = t.shape
    return t.transpose(0, 2, 1, 3).reshape(b, s, n * d)


def _to_chunks(t):
    b, h, s = t.shape[:3]
    return jnp.moveaxis(t.reshape(b, h, s // CHUNK, CHUNK, *t.shape[3:]), 2, 0)


def _from_chunks(t):
    t = jnp.moveaxis(t, 0, 2)
    return t.reshape(t.shape[0], t.shape[1], -1, *t.shape[4:])


def _flip(t):
    return jnp.flip(t, axis=2)


def _bidirectional(scan_fn, fwd_args, bwd_args):
    return scan_fn(*fwd_args) + _flip(scan_fn(*[_flip(a) for a in bwd_args]))


def _hgrn2_scan(q, k, v, log_f):
    bsz, nh, _, dk = q.shape
    dv = v.shape[-1]
    mask = jnp.tril(jnp.ones((CHUNK, CHUNK), bool))[:, :, None]

    def step(state, xs):
        qc, kc, vc, lfc = xs
        b = jnp.cumsum(lfc, axis=2)
        rel = b[:, :, :, None, :] - b[:, :, None, :, :]
        decay = jnp.exp(jnp.where(mask, rel, NEG_BIG))
        scores = jnp.einsum('bhtd,bhsd,bhtsd->bhts', qc, kc, decay)
        o = (jnp.einsum('bhts,bhsv->bhtv', scores, vc)
             + jnp.einsum('bhtd,bhdv->bhtv', qc * jnp.exp(b), state))
        b_last = b[:, :, -1:, :]
        state = (jnp.exp(b_last[:, :, 0, :])[..., None] * state
                 + jnp.einsum('bhsd,bhsv->bhdv', kc * jnp.exp(b_last - b), vc))
        return state, o

    s0 = jnp.zeros((bsz, nh, dk, dv), jnp.float32)
    _, o = lax.scan(step, s0, (_to_chunks(q), _to_chunks(k), _to_chunks(v), _to_chunks(log_f)))
    return _from_chunks(o)


def _mlstm_scan(q, k, v, log_i, log_f):
    bsz, nh, _, dh = q.shape
    mask = jnp.tril(jnp.ones((CHUNK, CHUNK), bool))

    def step(carry, xs):
        c_st, n_st, m_st = carry
        qc, kc, vc, ic, fc = xs
        b = jnp.cumsum(fc, axis=-1)
        d_intra = jnp.where(mask, b[..., :, None] - b[..., None, :] + ic[..., None, :], NEG_BIG)
        d_inter = b + m_st[..., None]
        m_t = jnp.maximum(d_inter, jnp.max(d_intra, axis=-1))
        w_intra = jnp.exp(d_intra - m_t[..., None])
        w_inter = jnp.exp(d_inter - m_t)
        qk = jnp.einsum('bhtd,bhsd->bhts', qc, kc) * w_intra
        num = (jnp.einsum('bhts,bhsv->bhtv', qk, vc)
               + w_inter[..., None] * jnp.einsum('bhtd,bhdv->bhtv', qc, c_st))
        den = jnp.sum(qk, axis=-1) + w_inter * jnp.einsum('bhtd,bhd->bht', qc, n_st)
        h = num / jnp.maximum(jnp.abs(den), jnp.exp(-m_t))[..., None]
        b_last = b[..., -1]
        g = b_last[..., None] - b + ic
        m_new = jnp.maximum(b_last + m_st, jnp.max(g, axis=-1))
        w_old = jnp.exp(b_last + m_st - m_new)
        w_s = jnp.exp(g - m_new[..., None])
        c_st = w_old[..., None, None] * c_st + jnp.einsum('bhs,bhsd,bhsv->bhdv', w_s, kc, vc)
        n_st = w_old[..., None] * n_st + jnp.einsum('bhs,bhsd->bhd', w_s, kc)
        return (c_st, n_st, m_new), h

    carry0 = (jnp.zeros((bsz, nh, dh, dh), jnp.float32),
              jnp.zeros((bsz, nh, dh), jnp.float32),
              jnp.zeros((bsz, nh), jnp.float32))
    _, h = lax.scan(step, carry0, (_to_chunks(q), _to_chunks(k), _to_chunks(v),
                                   _to_chunks(log_i), _to_chunks(log_f)))
    return _from_chunks(h)


def _centred_dwconv(t, w):
    pad = CONV_W // 2
    s = t.shape[1]
    tp = jnp.pad(t, ((0, 0), (pad, pad), (0, 0)))
    out = tp[:, 0:s] * w[0]
    for j in range(1, CONV_W):
        out = out + tp[:, j:j + s] * w[j]
    return out


def _even_mixer(x, w_in, gate_bias, lb_fwd, lb_bwd, conv_w, gn_a, gn_b, w_out):
    f32 = jnp.float32
    proj = x @ w_in
    (aq, af_f, af_b, ai, ag, bq, bk, bv, bo, bg) = jnp.split(
        proj, np.cumsum(_IN_SIZES)[:-1].tolist(), axis=-1)

    q_a = _heads(aq, A_HEADS).astype(f32)
    v_a = _heads(ai, A_HEADS).astype(f32)

    def log_forget(z, lb):
        lb = lb.reshape(A_HEADS, 1, A_DK)
        return jnp.logaddexp(jnp.log(jnp.maximum(lb, LB_FLOOR)), jnp.log1p(-lb)
                             + jax.nn.log_sigmoid(_heads(z, A_HEADS).astype(f32)))

    lf_f = log_forget(af_f, lb_fwd)
    lf_b = log_forget(af_b, lb_bwd)
    o_a = _bidirectional(_hgrn2_scan, (q_a, -jnp.expm1(lf_f), v_a, lf_f),
                         (q_a, -jnp.expm1(lf_b), v_a, lf_b))
    o_a = o_a * lax.rsqrt(jnp.mean(jnp.square(o_a), -1, keepdims=True) + GN_EPS)
    o_a = _merge(o_a) * gn_a * jax.nn.silu(ag.astype(f32))

    qk = jax.nn.silu(_centred_dwconv(jnp.concatenate([bq, bk], -1), conv_w))
    q_b = _heads(qk[..., :B_WIDTH], B_HEADS).astype(f32)
    k_b = _heads(qk[..., B_WIDTH:], B_HEADS).astype(f32) * (B_DH ** -0.5)
    v_b = _heads(bv, B_HEADS).astype(f32)
    gates = (bg + gate_bias).astype(f32)
    gates = gates.reshape(gates.shape[0], gates.shape[1], 4, B_HEADS).transpose(2, 0, 3, 1)
    li_f, li_b = gates[0], gates[1]
    lfm_f, lfm_b = jax.nn.log_sigmoid(gates[2]), jax.nn.log_sigmoid(gates[3])
    h_b = _bidirectional(_mlstm_scan, (q_b, k_b, v_b, li_f, lfm_f),
                         (q_b, k_b, v_b, li_b, lfm_b))
    mu = jnp.mean(h_b, -1, keepdims=True)
    h_b = (h_b - mu) * lax.rsqrt(jnp.mean(jnp.square(h_b - mu), -1, keepdims=True) + GN_EPS)
    h_b = _merge(h_b) * gn_b * jax.nn.sigmoid(bo.astype(f32))

    return jnp.concatenate([o_a, h_b], -1).astype(x.dtype) @ w_out


def _neighbourhood_attention(x, w_qkv, rpb, w_out):
    bsz, seq, _ = x.shape
    rows = seq // GRID_W
    wr = min(WIN_R, rows)
    qkv = (x @ w_qkv).reshape(bsz, rows, GRID_W, 3, NA_HEADS, NA_DH)
    qkv = qkv.transpose(3, 0, 4, 1, 2, 5)
    q, k, v = qkv[0] * (NA_DH ** -0.5), qkv[1], qkv[2]

    n_cb = GRID_W // COL_BLOCK
    qcol = np.arange(GRID_W).reshape(n_cb, COL_BLOCK)
    c0 = np.clip(qcol - WIN_C // 2, 0, GRID_W - WIN_C)
    band = np.clip(c0[:, 0], 0, GRID_W - COL_BAND)[:, None] + np.arange(COL_BAND)
    col_valid = (band[:, None, :] >= c0[:, :, None]) & (band[:, None, :] < c0[:, :, None] + WIN_C)
    col_idx = np.clip(band[:, None, :] - qcol[:, :, None] + WIN_C - 1, 0, 2 * WIN_C - 2)
    valid = jnp.asarray(col_valid)[:, :, None, :]
    rpb_c = rpb.astype(jnp.float32)[:, :, col_idx]

    def one_row(r):
        r0 = jnp.clip(r - wr // 2, 0, rows - wr)
        kr = lax.dynamic_slice_in_dim(k, r0, wr, axis=2)[:, :, :, band]
        vr = lax.dynamic_slice_in_dim(v, r0, wr, axis=2)[:, :, :, band]
        qr = lax.dynamic_index_in_dim(q, r, axis=2, keepdims=False)
        qr = qr.reshape(bsz, NA_HEADS, n_cb, COL_BLOCK, NA_DH)
        row_idx = r0 + jnp.arange(wr) - r + WIN_R - 1
        bias = jnp.take(rpb_c, row_idx, axis=1).transpose(0, 2, 3, 1, 4)
        s = jnp.einsum('bhnqd,bhrnkd->bhnqrk', qr, kr).astype(jnp.float32) + bias
        s = jnp.where(valid, s, NEG_BIG).reshape(bsz, NA_HEADS, n_cb, COL_BLOCK, wr * COL_BAND)
        p = jax.nn.softmax(s, axis=-1).reshape(bsz, NA_HEADS, n_cb, COL_BLOCK, wr, COL_BAND)
        o = jnp.einsum('bhnqrk,bhrnkd->bhnqd', p.astype(v.dtype), vr)
        return o.reshape(bsz, NA_HEADS, GRID_W, NA_DH)

    o = lax.map(one_row, jnp.arange(rows))
    o = o.transpose(1, 0, 3, 2, 4).reshape(bsz, seq, D_MODEL)
    return o @ w_out


def _layer_norm(t, g, b):
    t32 = t.astype(jnp.float32)
    mu = jnp.mean(t32, -1, keepdims=True)
    var = jnp.mean(jnp.square(t32 - mu), -1, keepdims=True)
    return ((t32 - mu) * lax.rsqrt(var + LN_EPS) * g + b).astype(t.dtype)


def _swiglu(t, wg, wu, wd):
    return (jax.nn.silu(t @ wg) * (t @ wu)) @ wd


def setup_inputs(seed: int = 0) -> dict:
    key = jax.random.key(seed)
    ks = jax.random.split(key, 20)
    f32 = jnp.float32

    def nrm(k, shape, scale):
        return jax.random.normal(k, shape, f32) * scale

    x = nrm(ks[0], (BATCH, SEQ, D_MODEL), 1.0)
    w_in_even = nrm(ks[1], (N_EVEN, D_MODEL, IN_COLS), D_MODEL ** -0.5)
    f_bias = jnp.tile(jnp.linspace(3.0, 6.0, B_HEADS, dtype=f32), 2)
    gate_bias_even = jnp.concatenate(
        [nrm(ks[2], (N_EVEN, 2 * B_HEADS), 0.1),
         f_bias + nrm(ks[3], (N_EVEN, 2 * B_HEADS), 0.1)], axis=-1)
    lb_raw = nrm(ks[4], (2, N_EVEN, A_KEY), 0.5)
    conv_qk = nrm(ks[5], (N_EVEN, CONV_W, 2 * B_WIDTH), CONV_W ** -0.5)
    gn_hgrn = 1.0 + nrm(ks[6], (N_EVEN, A_WIDTH), 0.02)
    gn_mlstm = 1.0 + nrm(ks[7], (N_EVEN, B_WIDTH), 0.02)
    w_out_even = nrm(ks[8], (N_EVEN, MIX_WIDTH, D_MODEL), BETA * MIX_WIDTH ** -0.5)
    w_qkv_odd = nrm(ks[9], (N_ODD, D_MODEL, 3 * D_MODEL), D_MODEL ** -0.5)
    rpb_odd = nrm(ks[10], (N_ODD, NA_HEADS, 2 * WIN_R - 1, 2 * WIN_C - 1), 0.05)
    w_out_odd = nrm(ks[11], (N_ODD, D_MODEL, D_MODEL), BETA * D_MODEL ** -0.5)
    ln_mix_g = 1.0 + nrm(ks[12], (DEPTH, D_MODEL), 0.02)
    ln_mix_b = nrm(ks[13], (DEPTH, D_MODEL), 0.02)
    ln_ffn_g = 1.0 + nrm(ks[14], (DEPTH, D_MODEL), 0.02)
    ln_ffn_b = nrm(ks[15], (DEPTH, D_MODEL), 0.02)
    w_ffn_gate = nrm(ks[16], (DEPTH, D_MODEL, FFN_HIDDEN), D_MODEL ** -0.5)
    w_ffn_up = nrm(ks[17], (DEPTH, D_MODEL, FFN_HIDDEN), D_MODEL ** -0.5)
    w_ffn_down = nrm(ks[18], (DEPTH, FFN_HIDDEN, D_MODEL), BETA * FFN_HIDDEN ** -0.5)
    return {"x": x, "w_in_even": w_in_even, "gate_bias_even": gate_bias_even,
            "lb_raw": lb_raw, "conv_qk": conv_qk, "gn_hgrn": gn_hgrn, "gn_mlstm": gn_mlstm,
            "w_out_even": w_out_even, "w_qkv_odd": w_qkv_odd, "rpb_odd": rpb_odd,
            "w_out_odd": w_out_odd, "ln_mix_g": ln_mix_g, "ln_mix_b": ln_mix_b,
            "ln_ffn_g": ln_ffn_g, "ln_ffn_b": ln_ffn_b, "w_ffn_gate": w_ffn_gate,
            "w_ffn_up": w_ffn_up, "w_ffn_down": w_ffn_down}


def reference(x, w_in_even, gate_bias_even, lb_raw, conv_qk, gn_hgrn, gn_mlstm,
              w_out_even, w_qkv_odd, rpb_odd, w_out_odd, ln_mix_g, ln_mix_b,
              ln_ffn_g, ln_ffn_b, w_ffn_gate, w_ffn_up, w_ffn_down):
    soft = jax.nn.softmax(lb_raw.astype(jnp.float32), axis=1)
    lower_bounds = jnp.cumsum(soft, axis=1) - soft[:, :1]
    h = x
    for layer in range(DEPTH):
        j = layer // 2
        if layer % 2 == 0:
            mix = _even_mixer(h, w_in_even[j], gate_bias_even[j], lower_bounds[0, j],
                              lower_bounds[1, j], conv_qk[j], gn_hgrn[j], gn_mlstm[j],
                              w_out_even[j])
        else:
            mix = _neighbourhood_attention(h, w_qkv_odd[j], rpb_odd[j], w_out_odd[j])
        h = _layer_norm(ALPHA * h + mix, ln_mix_g[layer], ln_mix_b[layer])
        h = _layer_norm(ALPHA * h + _swiglu(h, w_ffn_gate[layer], w_ffn_up[layer], w_ffn_down[layer]),
                        ln_ffn_g[layer], ln_ffn_b[layer])
    return h
```

```cpp
#include <hip/hip_runtime.h>
#include <hip/hip_cooperative_groups.h>
#include <cstdio>
#include <cstdint>
namespace cg = cooperative_groups;

#define LAS __attribute__((address_space(3)))
typedef unsigned short bf16_t;
typedef short bf16x8 __attribute__((ext_vector_type(8)));
typedef float f32x4 __attribute__((ext_vector_type(4)));
typedef unsigned u32x4 __attribute__((ext_vector_type(4)));
typedef unsigned u32x2 __attribute__((ext_vector_type(2)));
typedef short s16x4 __attribute__((ext_vector_type(4)));

constexpr int SEQ = 4096, DM = 1024, NTOK = 65536, NPANEL = 256;
constexpr int INC = 4624, INP = 4864, QKVN = 3072, FF = 2816, GUN = 5632;
constexpr int C_AQ = 0, C_AFF = 512, C_AFB = 1024, C_AI = 1536, C_AG = 2048, C_BQ = 2560, C_BK = 3072, C_BV = 3584, C_BO = 4096, C_BG = 4608;
constexpr float ALPHA = 1.681792830507429f;
constexpr float LN_EPS = 1e-5f, GN_EPS = 1e-6f;
constexpr size_t W_IN_ELEMS = (size_t)INP * DM, W_OUT_ELEMS = (size_t)DM * DM, W_GU_ELEMS = (size_t)GUN * DM, W_D_ELEMS = (size_t)DM * FF;
constexpr size_t OFF_WOUT = W_IN_ELEMS, OFF_WGU = OFF_WOUT + W_OUT_ELEMS, OFF_WD = OFF_WGU + W_GU_ELEMS, LAYER_W_ELEMS = OFF_WD + W_D_ELEMS;
constexpr size_t WS_WT = 0, WS_HB = WS_WT + 4 * LAYER_W_ELEMS * 2, WS_PROJ = WS_HB + (size_t)NTOK * DM * 2, WS_MIX = WS_PROJ + (size_t)NTOK * INP * 2, WS_END = WS_MIX + (size_t)NTOK * DM * 2;
constexpr size_t WS_BAR = WS_END, WS_TOTAL = WS_BAR + 16384;
constexpr int LDS_BYTES = 131072 + 16;

struct Params {
    const float* in[18];
    float* out;
    unsigned char* ws;
};

typedef float f32x2 __attribute__((ext_vector_type(2)));
typedef __bf16 bf16x2v __attribute__((ext_vector_type(2)));
__device__ __forceinline__ unsigned pk2(float lo, float hi) { const f32x2 f = {lo, hi}; const bf16x2v b = __builtin_convertvector(f, bf16x2v); return __builtin_bit_cast(unsigned, b); }
__device__ __forceinline__ float bf_lo(unsigned u) { return __uint_as_float(u << 16); }
__device__ __forceinline__ float bf_hi(unsigned u) { return __uint_as_float(u & 0xffff0000u); }
typedef _Float16 f16x2v __attribute__((ext_vector_type(2)));
__device__ __forceinline__ unsigned pkh2(float lo, float hi) { const f32x2 f = {lo, hi}; const f16x2v h = __builtin_convertvector(f, f16x2v); return __builtin_bit_cast(unsigned, h); }
__device__ __forceinline__ float h_lo(unsigned u) { const f16x2v h = __builtin_bit_cast(f16x2v, u); return (float)h[0]; }
__device__ __forceinline__ float h_hi(unsigned u) { const f16x2v h = __builtin_bit_cast(f16x2v, u); return (float)h[1]; }
__device__ __forceinline__ float bf1(bf16_t b) { return __uint_as_float(((unsigned)b) << 16); }
__device__ __forceinline__ float logf_(float x) { return __builtin_amdgcn_logf(x) * 0.6931471805599453f; }
__device__ __forceinline__ float exp2f_(float x) { return __builtin_amdgcn_exp2f(x); }
__device__ __forceinline__ float log2f_(float x) { return __builtin_amdgcn_logf(x); }
__device__ __forceinline__ float rcpf_(float x) { return __builtin_amdgcn_rcpf(x); }
__device__ __forceinline__ float sigmoidf_(float x) { return rcpf_(1.0f + __expf(-x)); }
__device__ __forceinline__ float siluf_(float x) { return x * rcpf_(1.0f + __expf(-x)); }
__device__ __forceinline__ int lane_id() { int l; asm volatile("v_mbcnt_lo_u32_b32 %0, -1, 0\n\tv_mbcnt_hi_u32_b32 %0, -1, %0" : "=v"(l)); return l; }
__device__ __forceinline__ int tid_fresh(int wv) { int t = wv * 64 + lane_id(); asm volatile("" : "+v"(t)); return t; }
__device__ __forceinline__ float wave_sum(float v) {
#pragma unroll
    for (int o = 1; o < 64; o <<= 1) v += __shfl_xor(v, o);
    return v;
}

namespace pg8 {
constexpr int BM = 256, BK = 64, HALF = 128, HTB = HALF * BK * 2, NXCD = 8, WGM = 8;
__device__ __forceinline__ int lds_byte(int r, int c) { const int st = (r >> 4) * 2 + (c >> 5), rr = r & 15, cc = c & 31, ob = rr * 64 + cc * 2; return st * 1024 + (ob ^ (((ob >> 9) & 1) << 5)); }
__device__ __forceinline__ void stage_rc(int b, int& R, int& C) { const int st = b / 1024, sb = b % 1024, swz = sb ^ (((sb >> 9) & 1) << 5); R = (st >> 1) * 16 + swz / 64; C = (st & 1) * 32 + (swz % 64) / 2; }
__device__ __forceinline__ int perm32(int rho) { const int n = rho >> 4, i = rho & 15; return 8 * (i >> 2) + 4 * n + (i & 3); }
struct Unit { int pm, pn; };
struct Gemm { const bf16_t* A; const bf16_t* Bt; int M, N, K; };
struct StaticOrder {
    int nM, nN, nwg, G, c;
    __device__ void init(int M, int N, int G_, int c_) { nM = M / BM; nN = N / BM; nwg = nM * nN; G = G_; c = c_; }
    __device__ bool next(int i, Unit& u) const {
        const long L = (long)i * G + c; if (L >= nwg) return false;
        int wgid = (int)L; { const int q = nwg / NXCD, r = nwg % NXCD, xcd = wgid % NXCD, off = wgid / NXCD; wgid = (xcd < r ? xcd * (q + 1) : r * (q + 1) + (xcd - r) * q) + off; }
        const int nig = WGM * nN, gid = wgid / nig, fm = gid * WGM, gsz = (nM - fm) < WGM ? (nM - fm) : WGM;
        u.pm = fm + ((wgid % nig) % gsz); u.pn = (wgid % nig) / gsz; return true;
    }
};
struct PanelOrder {
    int pm, nN;
    __device__ bool next(int i, Unit& u) const { if (i >= nN) return false; u.pm = pm; u.pn = i; return true; }
};
struct EpiStoreBf16 {
    static constexpr bool PERM = true, ALIGN = true;
    bf16_t* O; int ldc;
    __device__ __forceinline__ void operator()(const f32x4 (&acc)[2][2][4][2], const Unit& u, int wr, int wc, int fr, int fq) const {
        const int row0 = u.pm * BM + wr * 64 + fr, col0 = u.pn * BM + wc * 32 + 8 * fq;
#pragma unroll
        for (int ai = 0; ai < 2; ++ai)
#pragma unroll
            for (int m = 0; m < 4; ++m) { bf16_t* rowp = O + (size_t)(row0 + ai * HALF + m * 16) * ldc + col0;
#pragma unroll
                for (int bj = 0; bj < 2; ++bj) { const f32x4 v0 = acc[ai][bj][m][0], v1 = acc[ai][bj][m][1];
                    u32x4 w; w.x = pk2(v0[0], v0[1]); w.y = pk2(v0[2], v0[3]); w.z = pk2(v1[0], v1[1]); w.w = pk2(v1[2], v1[3]);
                    *(u32x4*)(rowp + bj * HALF) = w; }
                asm volatile("" ::: "memory"); }
    }
};
struct EpiSwiglu {
    static constexpr bool PERM = true, ALIGN = true;
    bf16_t* O; int ldc;
    __device__ __forceinline__ void operator()(const f32x4 (&acc)[2][2][4][2], const Unit& u, int wr, int wc, int fr, int fq) const {
        const int row0 = u.pm * BM + wr * 64 + fr, col0 = u.pn * HALF + wc * 32 + 8 * fq;
#pragma unroll
        for (int ai = 0; ai < 2; ++ai)
#pragma unroll
            for (int m = 0; m < 4; ++m) { bf16_t* rowp = O + (size_t)(row0 + ai * HALF + m * 16) * ldc + col0;
                float hv[8];
#pragma unroll
                for (int n = 0; n < 2; ++n)
#pragma unroll
                    for (int jj = 0; jj < 4; ++jj) { const float g = acc[ai][0][m][n][jj], uu = acc[ai][1][m][n][jj]; hv[n * 4 + jj] = siluf_(g) * uu; }
                u32x4 w; w.x = pk2(hv[0], hv[1]); w.y = pk2(hv[2], hv[3]); w.z = pk2(hv[4], hv[5]); w.w = pk2(hv[6], hv[7]);
                *(u32x4*)rowp = w;
                asm volatile("" ::: "memory"); }
    }
};
struct EpiResid {
    static constexpr bool PERM = false, ALIGN = false;
    unsigned short* Y; const unsigned short* R; float alpha; bool res_bf16;
    __device__ __forceinline__ void operator()(const f32x4 (&acc)[2][2][4][2], const Unit& u, int wr, int wc, int fr, int fq) const {
        const int row0 = u.pm * BM + wr * 64 + fr, col0 = u.pn * BM + wc * 32 + 4 * fq;
        const size_t off0 = (size_t)row0 * DM + col0;
        u32x2 hv[2][4][2][2];
#pragma unroll
        for (int ai = 0; ai < 2; ++ai)
#pragma unroll
            for (int m = 0; m < 4; ++m)
#pragma unroll
                for (int bj = 0; bj < 2; ++bj)
#pragma unroll
                    for (int n = 0; n < 2; ++n) hv[ai][m][bj][n] = *(const u32x2*)(R + off0 + (size_t)(ai * HALF + m * 16) * DM + bj * HALF + n * 16);
#pragma unroll
        for (int ai = 0; ai < 2; ++ai)
#pragma unroll
            for (int m = 0; m < 4; ++m)
#pragma unroll
                for (int bj = 0; bj < 2; ++bj)
#pragma unroll
                    for (int n = 0; n < 2; ++n) { const u32x2 w = hv[ai][m][bj][n];
                        const f32x4 r = res_bf16 ? (f32x4){bf_lo(w.x), bf_hi(w.x), bf_lo(w.y), bf_hi(w.y)} : (f32x4){h_lo(w.x), h_hi(w.x), h_lo(w.y), h_hi(w.y)};
                        const f32x4 y = r * alpha + acc[ai][bj][m][n]; u32x2 o; o.x = pkh2(y[0], y[1]); o.y = pkh2(y[2], y[3]);
                        *(u32x2*)(Y + off0 + (size_t)(ai * HALF + m * 16) * DM + bj * HALF + n * 16) = o; }
    }
};

template <class Epi, class Sched>
__device__ __forceinline__ void gemm_phase(LAS unsigned char* lds, const Gemm g, const Sched& S, const Epi& E, const int wv) {
    const int tid = tid_fresh(wv), wid = __builtin_amdgcn_readfirstlane(tid >> 6), lane = tid & 63, wr = wid >> 2, wc = wid & 3, fr = lane & 15, fq = lane >> 4;
    const int K = g.K, nt = K / BK;
    unsigned voffA[2], voffB[2];
#pragma unroll
    for (int i = 0; i < 2; ++i) { int R, C; stage_rc(tid * 16 + i * 8192, R, C); const int Rb = Epi::PERM ? ((R & ~31) + perm32(R & 31)) : R;
        voffA[i] = (unsigned)(R * K + C) * 2u; voffB[i] = (unsigned)(Rb * K + C) * 2u; }
    const size_t kstep = (size_t)(BK * 2);
    const size_t hstep = (size_t)HALF * K * 2;
    const size_t tstep = 2 * hstep;
    const unsigned ldsw = (unsigned)wid * 1024u;
    const int aoff = lds_byte(wr * 64 + fr, fq * 8), boff = lds_byte(wc * 32 + fr, fq * 8);
#define PG8_SA(b, h) (((b) * 2 + (h)) * HTB)
#define PG8_SB(b, h) ((4 + (b) * 2 + (h)) * HTB)
#define PG8_STAGE(bufoff, gbase, voff) do { _Pragma("unroll") for (int _i = 0; _i < 2; ++_i) \
        __builtin_amdgcn_global_load_lds((const unsigned*)((const char*)(gbase) + (voff)[_i]), (LAS unsigned*)(lds + (bufoff) + ldsw + _i * 8192), 16, 0, 0); } while (0)
#define PG8_LDA(dst, b, h) do { _Pragma("unroll") for (int m = 0; m < 4; ++m) _Pragma("unroll") for (int k = 0; k < 2; ++k) dst[m][k] = *(const LAS bf16x8*)(lds + PG8_SA(b, h) + aoff + m * 2048 + k * 1024); } while (0)
#define PG8_LDB(dst, b, h) do { _Pragma("unroll") for (int n = 0; n < 2; ++n) _Pragma("unroll") for (int k = 0; k < 2; ++k) dst[n][k] = *(const LAS bf16x8*)(lds + PG8_SB(b, h) + boff + n * 2048 + k * 1024); } while (0)
#define PG8_MMA(ai, bj, At, Bt) do { __builtin_amdgcn_s_setprio(1); _Pragma("unroll") for (int m = 0; m < 4; ++m) _Pragma("unroll") for (int n = 0; n < 2; ++n) _Pragma("unroll") for (int k = 0; k < 2; ++k) \
        acc[ai][bj][m][n] = __builtin_amdgcn_mfma_f32_16x16x32_bf16(Bt[n][k], At[m][k], acc[ai][bj][m][n], 0, 0, 0); __builtin_amdgcn_s_setprio(0); } while (0)
#define PG8_WAIT_V(n) asm volatile("s_waitcnt vmcnt(" #n ")" ::: "memory")
#define PG8_WAIT_L(n) asm volatile("s_waitcnt lgkmcnt(" #n ")" ::: "memory")
#define PG8_BAR __builtin_amdgcn_s_barrier()
#define PG8_SCHED __builtin_amdgcn_sched_barrier(0)
    Unit cur, nxt; int ui = 0;
    if (!S.next(0, cur)) return;
    f32x4 acc[2][2][4][2];
#pragma unroll
    for (int a = 0; a < 2; ++a)
#pragma unroll
        for (int b = 0; b < 2; ++b)
#pragma unroll
            for (int m = 0; m < 4; ++m)
#pragma unroll
                for (int n = 0; n < 2; ++n) acc[a][b][m][n] = (f32x4){0.f, 0.f, 0.f, 0.f};
    bf16x8 At[4][2], B0[2][2], B1[2][2];
    const char* cA = (const char*)g.A + (size_t)cur.pm * tstep; const char* cB = (const char*)g.Bt + (size_t)cur.pn * tstep;
    PG8_STAGE(PG8_SB(0, 0), cB, voffB); PG8_STAGE(PG8_SB(0, 1), cB + hstep, voffB); PG8_STAGE(PG8_SA(0, 0), cA, voffA); PG8_STAGE(PG8_SA(0, 1), cA + hstep, voffA);
    if (wr == 1) PG8_BAR;
    PG8_WAIT_V(2); PG8_BAR;
    PG8_STAGE(PG8_SB(1, 0), cB + kstep, voffB); PG8_STAGE(PG8_SA(1, 0), cA + kstep, voffA); PG8_STAGE(PG8_SB(1, 1), cB + hstep + kstep, voffB);
    PG8_WAIT_V(6); PG8_BAR;
    for (;;) {
        const bool has_next = S.next(ui + 1, nxt);
        const char* nA = has_next ? (const char*)g.A + (size_t)nxt.pm * tstep : cA; const char* nB = has_next ? (const char*)g.Bt + (size_t)nxt.pn * tstep : cB;
        for (int t = 0; t < nt; t += 2) {
            const bool last = (t == nt - 2);
            const char* a1 = cA + (size_t)(t + 1) * kstep;
            const char* a2 = last ? nA : cA + (size_t)(t + 2) * kstep; const char* b2 = last ? nB : cB + (size_t)(t + 2) * kstep;
            const char* a3 = a2 + kstep; const char* b3 = b2 + kstep;
            PG8_LDB(B0, 0, 0); PG8_LDB(B1, 0, 1); PG8_SCHED; PG8_LDA(At, 0, 0); PG8_STAGE(PG8_SA(1, 1), a1 + hstep, voffA);
            PG8_WAIT_V(8); PG8_WAIT_L(0); PG8_BAR; PG8_MMA(0, 0, At, B0); PG8_MMA(0, 1, At, B1); PG8_BAR; PG8_SCHED;
            PG8_LDA(At, 0, 1); PG8_STAGE(PG8_SB(0, 0), b2, voffB); PG8_STAGE(PG8_SB(0, 1), b2 + hstep, voffB); PG8_STAGE(PG8_SA(0, 0), a2, voffA);
            PG8_WAIT_V(8); PG8_WAIT_L(0); PG8_BAR; PG8_MMA(1, 0, At, B0); PG8_MMA(1, 1, At, B1); PG8_BAR; PG8_SCHED;
            PG8_LDB(B0, 1, 0); PG8_LDB(B1, 1, 1); PG8_SCHED; PG8_LDA(At, 1, 0); PG8_STAGE(PG8_SA(0, 1), a2 + hstep, voffA);
            PG8_WAIT_V(8); PG8_WAIT_L(0); PG8_BAR; PG8_MMA(0, 0, At, B0); PG8_MMA(0, 1, At, B1); PG8_BAR; PG8_SCHED;
            PG8_LDA(At, 1, 1); PG8_STAGE(PG8_SB(1, 0), b3, voffB); PG8_STAGE(PG8_SB(1, 1), b3 + hstep, voffB); PG8_STAGE(PG8_SA(1, 0), a3, voffA);
            PG8_WAIT_V(8); PG8_WAIT_L(0); PG8_BAR; PG8_MMA(1, 0, At, B0); PG8_MMA(1, 1, At, B1); PG8_BAR; PG8_SCHED;
        }
        if (Epi::ALIGN) { if (wr == 0) PG8_BAR; }
        E(acc, cur, wr, wc, fr, fq);
        if (!has_next) break;
#pragma unroll
        for (int a = 0; a < 2; ++a)
#pragma unroll
            for (int b = 0; b < 2; ++b)
#pragma unroll
                for (int m = 0; m < 4; ++m)
#pragma unroll
                    for (int n = 0; n < 2; ++n) acc[a][b][m][n] = (f32x4){0.f, 0.f, 0.f, 0.f};
        cur = nxt; cA = nA; cB = nB; ++ui;
        if (Epi::ALIGN) { if (wr == 1) PG8_BAR; }
    }
    PG8_WAIT_V(0);
    if (!Epi::ALIGN) { if (wr == 0) PG8_BAR; }
    PG8_BAR;
#undef PG8_SA
#undef PG8_SB
#undef PG8_STAGE
#undef PG8_LDA
#undef PG8_LDB
#undef PG8_MMA
#undef PG8_WAIT_V
#undef PG8_WAIT_L
#undef PG8_BAR
#undef PG8_SCHED
}
}

__device__ __forceinline__ void tr_item(const float* W, int ldw, int colbase, int nvalid, bf16_t* dst, int K, int n0, int k0, LAS float* scr, int lane) {
#pragma unroll 16
    for (int i = 0; i < 32; ++i) { const int kk = 2 * i + (lane >> 5), c = lane & 31;
        scr[kk * 33 + c] = (c < nvalid) ? W[(size_t)(k0 + kk) * ldw + colbase + c] : 0.0f; }
    asm volatile("s_waitcnt lgkmcnt(0)" ::: "memory");
    const int c = lane & 7;
#pragma unroll
    for (int j = 0; j < 4; ++j) { const int n = (lane >> 3) + 8 * j; const LAS float* s = scr + (8 * c) * 33 + n;
        u32x4 o; o.x = pk2(s[0 * 33], s[1 * 33]); o.y = pk2(s[2 * 33], s[3 * 33]); o.z = pk2(s[4 * 33], s[5 * 33]); o.w = pk2(s[6 * 33], s[7 * 33]);
        *(u32x4*)(dst + (size_t)(n0 + n) * K + k0 + 8 * c) = o; }
    asm volatile("s_waitcnt lgkmcnt(0)" ::: "memory");
}
__device__ __forceinline__ void tr_plain(const float* W, int ldw, int nsrc, int K, bf16_t* dst, int ndst, LAS float* scr, int lane, int gw, int NGW, int& base) {
    const int nblk = ndst / 32, nitems = nblk * (K / 64);
    const int first = ((gw - (base % NGW)) % NGW + NGW) % NGW;
    for (int it = first; it < nitems; it += NGW) { const int kb = it / nblk, nb = it % nblk, n0 = nb * 32;
        tr_item(W, ldw, n0, nsrc - n0, dst, K, n0, kb * 64, scr, lane); }
    base += nitems;
}
__device__ __forceinline__ void tr_gu(const float* Wg, const float* Wu, bf16_t* dst, LAS float* scr, int lane, int gw, int NGW, int& base) {
    const int nblk = GUN / 32, nitems = nblk * (DM / 64);
    const int first = ((gw - (base % NGW)) % NGW + NGW) % NGW;
    for (int it = first; it < nitems; it += NGW) { const int kb = it / nblk, nb = it % nblk, n0 = nb * 32;
        const int q = n0 >> 7, tile = q >> 1, isup = q & 1;
        tr_item(isup ? Wu : Wg, FF, tile * 128 + (n0 & 127), 32, dst, DM, n0, kb * 64, scr, lane); }
    base += nitems;
}
__device__ __forceinline__ void p0_phase(const Params& p, LAS unsigned char* lds, const int wv) {
    const int tid = tid_fresh(wv), wave = tid >> 6, lane = tid & 63;
    const int gw = blockIdx.x * 8 + wave, NGW = gridDim.x * 8;
    LAS float* scr = (LAS float*)(lds + wave * 16384);
    bf16_t* WT = (bf16_t*)(p.ws + WS_WT);
    int base = 0;
    for (int l = 0; l < 4; ++l) { const int j = l >> 1; bf16_t* wl = WT + (size_t)l * LAYER_W_ELEMS;
        if ((l & 1) == 0) {
            tr_plain(p.in[1] + (size_t)j * DM * INC, INC, INC, DM, wl, INP, scr, lane, gw, NGW, base);
            tr_plain(p.in[7] + (size_t)j * DM * DM, DM, DM, DM, wl + OFF_WOUT, DM, scr, lane, gw, NGW, base);
        } else {
            tr_plain(p.in[8] + (size_t)j * DM * QKVN, QKVN, QKVN, DM, wl, QKVN, scr, lane, gw, NGW, base);
            tr_plain(p.in[10] + (size_t)j * DM * DM, DM, DM, DM, wl + OFF_WOUT, DM, scr, lane, gw, NGW, base);
        }
        tr_gu(p.in[15] + (size_t)l * DM * FF, p.in[16] + (size_t)l * DM * FF, wl + OFF_WGU, scr, lane, gw, NGW, base);
        tr_plain(p.in[17] + (size_t)l * FF * DM, DM, DM, FF, wl + OFF_WD, DM, scr, lane, gw, NGW, base);
    }
    const f32x4* x4 = (const f32x4*)p.in[0]; u32x2* hb2 = (u32x2*)(p.ws + WS_HB); u32x2* r2 = (u32x2*)((char*)p.out + (size_t)NTOK * DM * 2);
    const size_t n4 = (size_t)NTOK * DM / 4;
    const size_t stride = (size_t)gridDim.x * 512;
    for (size_t i = (size_t)blockIdx.x * 512 + tid; i < n4; i += 4 * stride) {
        f32x4 v[4];
#pragma unroll
        for (int q = 0; q < 4; ++q) v[q] = (i + q * stride < n4) ? x4[i + q * stride] : (f32x4){0.f, 0.f, 0.f, 0.f};
#pragma unroll
        for (int q = 0; q < 4; ++q) if (i + q * stride < n4) { u32x2 o; o.x = pk2(v[q][0], v[q][1]); o.y = pk2(v[q][2], v[q][3]); hb2[i + q * stride] = o; u32x2 r; r.x = pkh2(v[q][0], v[q][1]); r.y = pkh2(v[q][2], v[q][3]); r2[i + q * stride] = r; }
    }
}

__device__ __forceinline__ void ln_panel(const unsigned short* Y, float* OUT, bf16_t* HB, unsigned short* R16, const float* gam, const float* bet, int pm, const bool last, const int wv) {
    const int tid = tid_fresh(wv), wave = tid >> 6, lane = tid & 63;
    f32x4 gv[4], bv[4];
#pragma unroll
    for (int j = 0; j < 4; ++j) { gv[j] = ((const f32x4*)gam)[lane + 64 * j]; bv[j] = ((const f32x4*)bet)[lane + 64 * j]; }
#pragma unroll 1
    for (int rg = 0; rg < 4; ++rg) { const size_t row0 = (size_t)pm * 256 + wave * 32 + rg * 8;
        u32x2 raw[8][4];
#pragma unroll
        for (int q = 0; q < 8; ++q)
#pragma unroll
            for (int j = 0; j < 4; ++j) raw[q][j] = ((const u32x2*)(Y + (row0 + q) * DM))[lane + 64 * j];
#pragma unroll
        for (int q = 0; q < 8; ++q) {
            f32x4 v[4]; float s = 0.f;
#pragma unroll
            for (int j = 0; j < 4; ++j) { v[j] = (f32x4){h_lo(raw[q][j].x), h_hi(raw[q][j].x), h_lo(raw[q][j].y), h_hi(raw[q][j].y)}; s += (v[j][0] + v[j][1]) + (v[j][2] + v[j][3]); }
            const float mean = wave_sum(s) * (1.f / DM); float s2 = 0.f;
#pragma unroll
            for (int j = 0; j < 4; ++j) { v[j] = v[j] - mean; s2 += (v[j][0] * v[j][0] + v[j][1] * v[j][1]) + (v[j][2] * v[j][2] + v[j][3] * v[j][3]); }
            const float rstd = 1.0f / sqrtf(wave_sum(s2) * (1.f / DM) + LN_EPS);
            f32x4* xr = (f32x4*)(OUT + (row0 + q) * DM) + lane; u32x2* o8 = (u32x2*)(HB + (row0 + q) * DM) + lane; u32x2* r8 = (u32x2*)(R16 + (row0 + q) * DM) + lane;
#pragma unroll
            for (int j = 0; j < 4; ++j) { const f32x4 y = v[j] * rstd * gv[j] + bv[j];
                if (last) xr[64 * j] = y;
                else { u32x2 o; o.x = pk2(y[0], y[1]); o.y = pk2(y[2], y[3]); o8[64 * j] = o; u32x2 r; r.x = pkh2(y[0], y[1]); r.y = pkh2(y[2], y[3]); r8[64 * j] = r; } }
        }
    }
}
__device__ __forceinline__ void gemm_ln_phase(LAS unsigned char* lds, const bf16_t* A, const bf16_t* Bt, int K, unsigned short* Y, float* OUT, bf16_t* HB, unsigned short* R16, const float* gam, const float* bet, const bool last, const int wv) {
    for (int pm = blockIdx.x; pm < NPANEL; pm += gridDim.x) {
        pg8::PanelOrder S; S.pm = pm; S.nN = 4;
        pg8::EpiResid E; E.Y = Y; E.R = last ? (const unsigned short*)HB : (const unsigned short*)R16; E.alpha = ALPHA; E.res_bf16 = last;
        pg8::Gemm g; g.A = A; g.Bt = Bt; g.M = NTOK; g.N = DM; g.K = K;
        pg8::gemm_phase(lds, g, S, E, wv);
        __syncthreads();
        ln_panel(Y, OUT, HB, R16, gam, bet, pm, last, wv);
        __syncthreads();
    }
}

__device__ __forceinline__ void conv_phase(const Params& p, int j, const int wv) {
    const bf16_t* proj = (const bf16_t*)(p.ws + WS_PROJ); bf16_t* mix = (bf16_t*)(p.ws + WS_MIX);
    const float* cw = p.in[4] + (size_t)j * 5 * DM;
    const size_t total = (size_t)NTOK * 128, stride = (size_t)gridDim.x * 512;
    const int tid = tid_fresh(wv);
    const int c = (tid & 127) * 8;
    f32x4 w0[5], w1[5];
#pragma unroll
    for (int jj = 0; jj < 5; ++jj) { w0[jj] = *(const f32x4*)(cw + jj * DM + c); w1[jj] = *(const f32x4*)(cw + jj * DM + c + 4); }
    const float sc = (c >= 512) ? 0.08838834764831845f : 1.0f;
    for (size_t idx = (size_t)blockIdx.x * 512 + tid; idx < total; idx += 2 * stride) {
        u32x4 xv[2][5];
#pragma unroll
        for (int q = 0; q < 2; ++q) { const size_t id = idx + q * stride; const int tok = (int)(id >> 7), t = tok & (SEQ - 1);
#pragma unroll
            for (int jj = 0; jj < 5; ++jj) { const int tt = t + jj - 2;
                xv[q][jj] = (id < total && tt >= 0 && tt < SEQ) ? *(const u32x4*)(proj + (size_t)(tok + jj - 2) * INP + C_BQ + c) : (u32x4){0u, 0u, 0u, 0u}; } }
#pragma unroll
        for (int q = 0; q < 2; ++q) { const size_t id = idx + q * stride; if (id >= total) break; const int tok = (int)(id >> 7);
            float a[8];
#pragma unroll
            for (int i = 0; i < 8; ++i) a[i] = 0.f;
#pragma unroll
            for (int jj = 0; jj < 5; ++jj) { const u32x4 x = xv[q][jj];
                a[0] += bf_lo(x.x) * w0[jj][0]; a[1] += bf_hi(x.x) * w0[jj][1]; a[2] += bf_lo(x.y) * w0[jj][2]; a[3] += bf_hi(x.y) * w0[jj][3];
                a[4] += bf_lo(x.z) * w1[jj][0]; a[5] += bf_hi(x.z) * w1[jj][1]; a[6] += bf_lo(x.w) * w1[jj][2]; a[7] += bf_hi(x.w) * w1[jj][3]; }
#pragma unroll
            for (int i = 0; i < 8; ++i) a[i] = siluf_(a[i]) * sc;
            u32x4 o; o.x = pk2(a[0], a[1]); o.y = pk2(a[2], a[3]); o.z = pk2(a[4], a[5]); o.w = pk2(a[6], a[7]);
            *(u32x4*)(mix + (size_t)tok * DM + c) = o; }
    }
}

template <bool ML>
__device__ __forceinline__ void chunk_scan(const Params& p, int j, int b, int h, int dir, LAS unsigned char* lds, const int wv) {
    constexpr int RS = 136, RT = 144, NCH = SEQ / 32;
    constexpr int BUF = (32 * RS * 2 + 32 * RT * 2) * 2 + 512;
    bf16_t* proj = (bf16_t*)(p.ws + WS_PROJ); const bf16_t* mix = (const bf16_t*)(p.ws + WS_MIX);
    const size_t rowbase = (size_t)b * SEQ;
    const int zc = (dir ? C_AFB : C_AFF) + h * 128;
    const int ocol = ML ? ((dir ? C_BK : C_BQ) + h * 128) : zc;
    if (wv >= 4) {
        const int gtid = tid_fresh(wv) - 256, dp = gtid >> 2, tq = gtid & 3, d = 2 * dp, vs_s = gtid >> 4, vs_c = (gtid & 15) * 8;
        float lb[2] = {0.f, 0.f}, oml[2] = {1.f, 1.f}, bi = 0.f, bff = 0.f;
        if (ML) { bi = p.in[2][j * 16 + dir * 4 + h]; bff = p.in[2][j * 16 + (2 + dir) * 4 + h]; }
        else if (j != 0) {
#pragma unroll
            for (int e = 0; e < 2; ++e) { const float r0 = p.in[3][dir * 1024 + h * 128 + d + e], r1 = p.in[3][dir * 1024 + 512 + h * 128 + d + e]; oml[e] = rcpf_(1.0f + __expf(r1 - r0)); lb[e] = 1.0f - oml[e]; } }
        unsigned pq[8], pg[8]; bf16_t pgi[8], pgf[8]; u32x4 pv0, pv1;
        const unsigned lrow = (unsigned)(dir ? (24 - tq * 8) : tq * 8), lrowv = (unsigned)(dir ? (15 - vs_s) : vs_s);
        const unsigned lq = ML ? (lrow * DM + h * 128 + d) * 2u : (lrow * INP + C_AQ + h * 128 + d) * 2u;
        const unsigned lg = ML ? (lrow * DM + 512 + h * 128 + d) * 2u : (lrow * INP + zc + d) * 2u;
        const unsigned lgi = (lrow * INP + C_BG + dir * 4 + h) * 2u, lgf = (lrow * INP + C_BG + (2 + dir) * 4 + h) * 2u;
        const unsigned lv = (lrowv * INP + (ML ? C_BV : C_AI) + h * 128 + vs_c) * 2u;
        const char* gproj = (const char*)proj; const char* gmix = (const char*)mix;
#define SCAN_LOAD(c) do { \
        _Pragma("unroll") for (int i = 0; i < 8; ++i) { const size_t urow = rowbase + (size_t)(dir ? (SEQ - 32 - (c) * 32 + 7 - i) : ((c) * 32 + i)); \
            if (ML) { pq[i] = *(const unsigned*)(gmix + urow * (DM * 2) + lq); pg[i] = *(const unsigned*)(gmix + urow * (DM * 2) + lg); \
                      pgi[i] = *(const bf16_t*)(gproj + urow * (INP * 2) + lgi); pgf[i] = *(const bf16_t*)(gproj + urow * (INP * 2) + lgf); } \
            else { pq[i] = *(const unsigned*)(gproj + urow * (INP * 2) + lq); pg[i] = *(const unsigned*)(gproj + urow * (INP * 2) + lg); } } \
        { const size_t u0 = rowbase + (size_t)(dir ? (SEQ - 32 - (c) * 32 + 16) : ((c) * 32)), u1 = rowbase + (size_t)(dir ? (SEQ - 32 - (c) * 32) : ((c) * 32 + 16)); \
          pv0 = *(const u32x4*)(gproj + u0 * (INP * 2) + lv); pv1 = *(const u32x4*)(gproj + u1 * (INP * 2) + lv); } } while (0)
        float kk[2][8], qv[2][8], liv[8], cs[2][8], run[2];
#define SCAN_GATE_A(c) do { \
        LAS bf16_t* Vs = (LAS bf16_t*)(lds + ((c) & 1) * BUF) + 64 * RS + 32 * RT; \
        *(LAS u32x4*)(Vs + vs_s * RT + vs_c) = pv0; *(LAS u32x4*)(Vs + (vs_s + 16) * RT + vs_c) = pv1; \
        run[0] = 0.f; run[1] = 0.f; \
        _Pragma("unroll") for (int i = 0; i < 8; ++i) { \
            float lfs = 0.f; \
            if (ML) { liv[i] = (bf1(pgi[i]) + bi) * 1.4426950408889634f; const float x = (bf1(pgf[i]) + bff) * 1.4426950408889634f; lfs = fminf(x, 0.f) - log2f_(1.0f + exp2f_(-fabsf(x))); } else liv[i] = 0.f; \
            _Pragma("unroll") for (int e = 0; e < 2; ++e) { \
                qv[e][i] = e ? bf_hi(pq[i]) : bf_lo(pq[i]); const float gval = e ? bf_hi(pg[i]) : bf_lo(pg[i]); float lf; \
                if (ML) { kk[e][i] = gval; lf = lfs; } \
                else { const float z = gval; const float ex = __expf(-fabsf(z)), r = rcpf_(1.0f + ex); const float sg = (z >= 0.f) ? r : ex * r, sgm = (z >= 0.f) ? ex * r : r; \
                    kk[e][i] = oml[e] * sgm; \
                    lf = log2f_(lb[e] + oml[e] * sg); } \
                run[e] += lf; cs[e][i] = run[e]; } } } while (0)
#define SCAN_GATE_B(c) do { \
        LAS bf16_t* Qh = (LAS bf16_t*)(lds + ((c) & 1) * BUF); LAS bf16_t* Kh = Qh + 32 * RS; LAS bf16_t* Kt = Kh + 32 * RS; LAS float* dl = (LAS float*)(Kt + 64 * RT); \
        float prefix[2], blast[2], edl[2]; \
        _Pragma("unroll") for (int e = 0; e < 2; ++e) { const float x1 = __shfl_xor(run[e], 1), x2 = __shfl_xor(run[e], 2), x3 = __shfl_xor(run[e], 3); \
            prefix[e] = (tq == 0) ? 0.f : (tq == 1) ? x1 : (tq == 2) ? (x2 + x3) : (x1 + x2 + x3); blast[e] = (run[e] + x1) + (x2 + x3); edl[e] = exp2f_(blast[e]); } \
        _Pragma("unroll") for (int i = 0; i < 8; ++i) { const int t = tq * 8 + i; float qh[2], kh[2], kt[2]; \
            _Pragma("unroll") for (int e = 0; e < 2; ++e) { const float bt = prefix[e] + cs[e][i]; \
                qh[e] = qv[e][i] * exp2f_(bt); kh[e] = kk[e][i] * exp2f_(liv[i] - bt); kt[e] = kh[e] * edl[e]; } \
            *(LAS unsigned*)(Qh + t * RS + d) = pk2(qh[0], qh[1]); *(LAS unsigned*)(Kh + t * RS + d) = pk2(kh[0], kh[1]); *(LAS unsigned*)(Kt + t * RT + d) = pk2(kt[0], kt[1]); } \
        if (tq == 0) { dl[d] = edl[0]; dl[d + 1] = edl[1]; } } while (0)
#define SCAN_BAR() asm volatile("s_waitcnt lgkmcnt(0)\n\ts_barrier" ::: "memory")
        SCAN_LOAD(0);
        SCAN_GATE_A(0);
        SCAN_LOAD(1);
        SCAN_GATE_B(0);
        SCAN_BAR();
#pragma unroll 1
        for (int c = 0; c < NCH; ++c) {
            if (c + 1 < NCH) { SCAN_GATE_A(c + 1); { const int cn = (c + 2 < NCH) ? (c + 2) : (NCH - 1); SCAN_LOAD(cn); } SCAN_GATE_B(c + 1); }
            SCAN_BAR();
        }
#undef SCAN_LOAD
#undef SCAN_GATE_A
#undef SCAN_GATE_B
#undef SCAN_BAR
    } else {
        const int tid = tid_fresh(wv), wave = wv, lane = tid & 63, li = lane & 15, quad = lane >> 4;
        f32x4 Macc[2][8], nacc[8];
#pragma unroll
        for (int i = 0; i < 8; ++i) { Macc[0][i] = (f32x4){0.f, 0.f, 0.f, 0.f}; Macc[1][i] = (f32x4){0.f, 0.f, 0.f, 0.f}; nacc[i] = (f32x4){0.f, 0.f, 0.f, 0.f}; }
        union { bf16x8 v; unsigned u[4]; } ones; ones.u[0] = ones.u[1] = ones.u[2] = ones.u[3] = 0x3F803F80u;
        asm volatile("s_waitcnt lgkmcnt(0)\n\ts_barrier" ::: "memory");
#pragma unroll 1
        for (int c = 0; c < NCH; ++c) {
            const LAS bf16_t* Qh = (const LAS bf16_t*)(lds + (c & 1) * BUF); const LAS bf16_t* Kh = Qh + 32 * RS; const LAS bf16_t* Kt = Kh + 32 * RS; const LAS bf16_t* Vs = Kt + 32 * RT; const LAS float* dl = (const LAS float*)(Vs + 32 * RT);
            f32x4 at00 = {0.f, 0.f, 0.f, 0.f}, at01 = at00, at11 = at00;
#pragma unroll
            for (int ks = 0; ks < 4; ++ks) {
                const bf16x8 kf0 = *(const LAS bf16x8*)(Kh + li * RS + ks * 32 + quad * 8), kf1 = *(const LAS bf16x8*)(Kh + (16 + li) * RS + ks * 32 + quad * 8);
                const bf16x8 qf0 = *(const LAS bf16x8*)(Qh + li * RS + ks * 32 + quad * 8), qf1 = *(const LAS bf16x8*)(Qh + (16 + li) * RS + ks * 32 + quad * 8);
                at00 = __builtin_amdgcn_mfma_f32_16x16x32_bf16(kf0, qf0, at00, 0, 0, 0);
                at01 = __builtin_amdgcn_mfma_f32_16x16x32_bf16(kf0, qf1, at01, 0, 0, 0);
                at11 = __builtin_amdgcn_mfma_f32_16x16x32_bf16(kf1, qf1, at11, 0, 0, 0);
            }
#pragma unroll
            for (int jj = 0; jj < 4; ++jj) { const bool keep = (quad * 4 + jj) <= li; at00[jj] = keep ? at00[jj] : 0.f; at11[jj] = keep ? at11[jj] : 0.f; }
            union { bf16x8 v; unsigned u[4]; } pb0, pb1;
            pb0.u[0] = pk2(at00[0], at00[1]); pb0.u[1] = pk2(at00[2], at00[3]); pb0.u[2] = 0u; pb0.u[3] = 0u;
            pb1.u[0] = pk2(at01[0], at01[1]); pb1.u[1] = pk2(at01[2], at01[3]); pb1.u[2] = pk2(at11[0], at11[1]); pb1.u[3] = pk2(at11[2], at11[3]);
            bf16x8 av[2]; f32x4 ot[2][2], den0 = {0.f, 0.f, 0.f, 0.f}, den1 = den0;
#pragma unroll
            for (int ct = 0; ct < 2; ++ct) { const int col0 = 32 * wave + 16 * ct;
                const s16x4 va0 = __builtin_amdgcn_ds_read_tr16_b64_v4i16((LAS s16x4*)(Vs + (quad * 4 + (li >> 2)) * RT + col0 + (li & 3) * 4));
                const s16x4 va1 = __builtin_amdgcn_ds_read_tr16_b64_v4i16((LAS s16x4*)(Vs + (16 + quad * 4 + (li >> 2)) * RT + col0 + (li & 3) * 4));
                av[ct] = (bf16x8){va0[0], va0[1], va0[2], va0[3], va1[0], va1[1], va1[2], va1[3]};
                ot[ct][0] = __builtin_amdgcn_mfma_f32_16x16x32_bf16(av[ct], pb0.v, (f32x4){0.f, 0.f, 0.f, 0.f}, 0, 0, 0);
                ot[ct][1] = __builtin_amdgcn_mfma_f32_16x16x32_bf16(av[ct], pb1.v, (f32x4){0.f, 0.f, 0.f, 0.f}, 0, 0, 0); }
            if (ML) { den0 = __builtin_amdgcn_mfma_f32_16x16x32_bf16(ones.v, pb0.v, den0, 0, 0, 0); den1 = __builtin_amdgcn_mfma_f32_16x16x32_bf16(ones.v, pb1.v, den1, 0, 0, 0); }
#pragma unroll
            for (int k2 = 0; k2 < 4; ++k2) {
                union { bf16x8 v; unsigned u[4]; u32x2 h2[2]; } am, an, q0, q1;
                q0.h2[0] = *(const LAS u32x2*)(Qh + li * RS + (2 * k2) * 16 + quad * 4); q0.h2[1] = *(const LAS u32x2*)(Qh + li * RS + (2 * k2 + 1) * 16 + quad * 4);
                q1.h2[0] = *(const LAS u32x2*)(Qh + (16 + li) * RS + (2 * k2) * 16 + quad * 4); q1.h2[1] = *(const LAS u32x2*)(Qh + (16 + li) * RS + (2 * k2 + 1) * 16 + quad * 4);
#pragma unroll
                for (int ct = 0; ct < 2; ++ct) {
                    am.u[0] = pk2(Macc[ct][2 * k2][0], Macc[ct][2 * k2][1]); am.u[1] = pk2(Macc[ct][2 * k2][2], Macc[ct][2 * k2][3]); am.u[2] = pk2(Macc[ct][2 * k2 + 1][0], Macc[ct][2 * k2 + 1][1]); am.u[3] = pk2(Macc[ct][2 * k2 + 1][2], Macc[ct][2 * k2 + 1][3]);
                    ot[ct][0] = __builtin_amdgcn_mfma_f32_16x16x32_bf16(am.v, q0.v, ot[ct][0], 0, 0, 0);
                    ot[ct][1] = __builtin_amdgcn_mfma_f32_16x16x32_bf16(am.v, q1.v, ot[ct][1], 0, 0, 0); }
                if (ML) {
                    an.u[0] = pk2(nacc[2 * k2][0], nacc[2 * k2][1]); an.u[1] = pk2(nacc[2 * k2][2], nacc[2 * k2][3]); an.u[2] = pk2(nacc[2 * k2 + 1][0], nacc[2 * k2 + 1][1]); an.u[3] = pk2(nacc[2 * k2 + 1][2], nacc[2 * k2 + 1][3]);
                    den0 = __builtin_amdgcn_mfma_f32_16x16x32_bf16(an.v, q0.v, den0, 0, 0, 0);
                    den1 = __builtin_amdgcn_mfma_f32_16x16x32_bf16(an.v, q1.v, den1, 0, 0, 0);
                }
            }
#pragma unroll
            for (int tt = 0; tt < 2; ++tt) { float inv = 1.0f;
                if (ML) { const f32x4 dn = tt ? den1 : den0; inv = rcpf_(fmaxf(fabsf(dn[0]), 1.0f)); }
                const int g = c * 32 + tt * 16 + li; const size_t row = rowbase + (dir ? (SEQ - 1 - g) : g);
#pragma unroll
                for (int ct = 0; ct < 2; ++ct) { const f32x4 o = ot[ct][tt] * inv; u32x2 w; w.x = pk2(o[0], o[1]); w.y = pk2(o[2], o[3]);
                    *(u32x2*)(proj + row * INP + ocol + 32 * wave + 16 * ct + quad * 4) = w; } }
#pragma unroll
            for (int rt = 0; rt < 8; ++rt) {
                const s16x4 k0 = __builtin_amdgcn_ds_read_tr16_b64_v4i16((LAS s16x4*)(Kt + (quad * 4 + (li >> 2)) * RT + rt * 16 + (li & 3) * 4));
                const s16x4 k1 = __builtin_amdgcn_ds_read_tr16_b64_v4i16((LAS s16x4*)(Kt + (16 + quad * 4 + (li >> 2)) * RT + rt * 16 + (li & 3) * 4));
                const bf16x8 ka = {k0[0], k0[1], k0[2], k0[3], k1[0], k1[1], k1[2], k1[3]};
                const f32x4 dlv = *(const LAS f32x4*)(dl + rt * 16 + quad * 4);
                Macc[0][rt] = __builtin_amdgcn_mfma_f32_16x16x32_bf16(ka, av[0], Macc[0][rt] * dlv, 0, 0, 0);
                Macc[1][rt] = __builtin_amdgcn_mfma_f32_16x16x32_bf16(ka, av[1], Macc[1][rt] * dlv, 0, 0, 0);
                if (ML) nacc[rt] = __builtin_amdgcn_mfma_f32_16x16x32_bf16(ka, ones.v, nacc[rt] * dlv, 0, 0, 0);
            }
            asm volatile("s_waitcnt lgkmcnt(0)\n\ts_barrier" ::: "memory");
        }
    }
    __syncthreads();
}
__device__ __forceinline__ void scan_phase(const Params& p, int j, LAS unsigned char* lds, const int wv) {
    for (int chain = blockIdx.x; chain < 256; chain += gridDim.x) {
        const int type = chain >> 7, rem = chain & 127, dir = rem & 1, h = (rem >> 1) & 3, b = rem >> 3;
        if (type == 0) chunk_scan<false>(p, j, b, h, dir, lds, wv); else chunk_scan<true>(p, j, b, h, dir, lds, wv);
    }
}

__device__ __forceinline__ void combine_phase(const Params& p, int j, const int wv) {
    const bf16_t* proj = (const bf16_t*)(p.ws + WS_PROJ); bf16_t* mix = (bf16_t*)(p.ws + WS_MIX);
    const int tid = tid_fresh(wv), wave = tid >> 6, lane = tid & 63;
    const int isB = lane >> 5, cc = (lane & 31) * 16;
    const int c1 = isB ? C_BQ : C_AFF, c2 = isB ? C_BK : C_AFB, c3 = isB ? C_BO : C_AG;
    const float* gn = (isB ? p.in[6] : p.in[5]) + (size_t)j * 512 + cc;
    float gnv[16];
#pragma unroll
    for (int i = 0; i < 16; ++i) gnv[i] = gn[i];
    const int tstride = gridDim.x * 8;
    for (int tok0 = blockIdx.x * 8 + wave; tok0 < NTOK; tok0 += 2 * tstride) {
        u32x4 x1a[2], x1b[2], x2a[2], x2b[2], ga[2], gb[2];
#pragma unroll
        for (int q = 0; q < 2; ++q) { const int tok = min(tok0 + q * tstride, NTOK - 1); const bf16_t* rp = proj + (size_t)tok * INP;
            x1a[q] = *(const u32x4*)(rp + c1 + cc); x1b[q] = *(const u32x4*)(rp + c1 + cc + 8);
            x2a[q] = *(const u32x4*)(rp + c2 + cc); x2b[q] = *(const u32x4*)(rp + c2 + cc + 8);
            ga[q] = *(const u32x4*)(rp + c3 + cc); gb[q] = *(const u32x4*)(rp + c3 + cc + 8); }
#pragma unroll
        for (int q = 0; q < 2; ++q) { const int tok = tok0 + q * tstride;
            float s[16], g[16];
            const unsigned x1w[8] = {x1a[q].x, x1a[q].y, x1a[q].z, x1a[q].w, x1b[q].x, x1b[q].y, x1b[q].z, x1b[q].w};
            const unsigned x2w[8] = {x2a[q].x, x2a[q].y, x2a[q].z, x2a[q].w, x2b[q].x, x2b[q].y, x2b[q].z, x2b[q].w};
            const unsigned gw[8] = {ga[q].x, ga[q].y, ga[q].z, ga[q].w, gb[q].x, gb[q].y, gb[q].z, gb[q].w};
#pragma unroll
            for (int i = 0; i < 8; ++i) { s[2 * i] = bf_lo(x1w[i]) + bf_lo(x2w[i]); s[2 * i + 1] = bf_hi(x1w[i]) + bf_hi(x2w[i]); g[2 * i] = bf_lo(gw[i]); g[2 * i + 1] = bf_hi(gw[i]); }
            float sum = 0.f;
#pragma unroll
            for (int i = 0; i < 16; ++i) sum += s[i];
            sum += __shfl_xor(sum, 1); sum += __shfl_xor(sum, 2); sum += __shfl_xor(sum, 4);
            const float mu = isB ? sum * (1.f / 128.f) : 0.f;
            float sq = 0.f;
#pragma unroll
            for (int i = 0; i < 16; ++i) { s[i] -= mu; sq += s[i] * s[i]; }
            sq += __shfl_xor(sq, 1); sq += __shfl_xor(sq, 2); sq += __shfl_xor(sq, 4);
            const float rs = __builtin_amdgcn_rsqf(sq * (1.f / 128.f) + GN_EPS);
            float o[16];
#pragma unroll
            for (int i = 0; i < 16; ++i) { const float act = isB ? sigmoidf_(g[i]) : siluf_(g[i]); o[i] = s[i] * rs * gnv[i] * act; }
            u32x4 oa, ob; oa.x = pk2(o[0], o[1]); oa.y = pk2(o[2], o[3]); oa.z = pk2(o[4], o[5]); oa.w = pk2(o[6], o[7]);
            ob.x = pk2(o[8], o[9]); ob.y = pk2(o[10], o[11]); ob.z = pk2(o[12], o[13]); ob.w = pk2(o[14], o[15]);
            if (tok < NTOK) { bf16_t* op = mix + (size_t)tok * DM + isB * 512 + cc; *(u32x4*)op = oa; *(u32x4*)(op + 8) = ob; }
        }
    }
}

__device__ __forceinline__ void na_phase(const Params& p, int j, LAS unsigned char* lds, const int wv) {
    const char* gq = (const char*)(p.ws + WS_PROJ); char* gm = (char*)(p.ws + WS_MIX);
    const float* rpb = p.in[9] + (size_t)j * 32 * 15 * 31;
    const int wave = wv;
    LAS bf16_t* Vs = (LAS bf16_t*)(lds + wave * 16384);
    const int NGW = gridDim.x * 8;
    constexpr size_t TOKB = (size_t)QKVN * 2;
    for (int gw = blockIdx.x * 8 + wave; gw < 2048; gw += NGW) {
        int lane = (int)__builtin_amdgcn_mbcnt_hi(~0u, __builtin_amdgcn_mbcnt_lo(~0u, 0u)); asm volatile("" : "+v"(lane));
        const int li = lane & 15, quad = lane >> 4;
        const int combo = gw & 127, head = combo >> 2, n = combo & 3, b = gw >> 7;
        const int band0 = (n == 0) ? 0 : (n == 1) ? 8 : (n == 2) ? 24 : 32;
        const int qc = n * 16 + li, c0q = min(max(qc - 8, 0), 48);
        const unsigned klane = (unsigned)((li * QKVN + DM + head * 32 + quad * 8) * 2);
        const unsigned vlane = (unsigned)(((lane >> 2) * QKVN + 2 * DM + head * 32 + (lane & 3) * 8) * 2);
        const size_t qadj = (size_t)n * 16 * TOKB - (size_t)DM * 2;
        const unsigned olane = (unsigned)((qc * DM + head * 32 + quad * 4) * 2);
        int cur_dr = 99;
        unsigned biasp[16][2];
#pragma unroll
        for (int t = 0; t < 16; ++t) { biasp[t][0] = 0u; biasp[t][1] = 0u; }
        bf16x8 qf, kf[16];
        { const size_t bt0 = (size_t)b * SEQ + band0;
          qf = *(const bf16x8*)((uintptr_t)gq + ((size_t)b * SEQ * TOKB + qadj) + klane);
#pragma unroll
          for (int t = 0; t < 16; ++t) kf[t] = *(const bf16x8*)(gq + (bt0 + (t >> 1) * 64 + (t & 1) * 16) * TOKB + klane);
#pragma unroll
          for (int it = 0; it < 16; ++it)
              __builtin_amdgcn_global_load_lds((const unsigned*)(gq + (bt0 + (it >> 1) * 64 + (it & 1) * 16) * TOKB + vlane), (LAS unsigned*)(Vs + it * 512), 16, 0, 0); }
        int rot = 0;
#pragma unroll 1
        for (int r = 0; r < 64; ++r) {
            const int r0 = min(max(r - 4, 0), 56), dr = r0 - r;
            if (dr != cur_dr) {
#pragma unroll
                for (int t = 0; t < 16; ++t) { float bv[4];
#pragma unroll
                    for (int jj = 0; jj < 4; ++jj) { const int kc = band0 + (t & 1) * 16 + quad * 4 + jj; const bool valid = (kc >= c0q) && (kc < c0q + 16);
                        const int ri = dr + (t >> 1) + 7, ci = kc - qc + 15;
                        bv[jj] = valid ? rpb[(head * 15 + ri) * 31 + ci] : -1e30f; }
                    biasp[t][0] = pk2(bv[0] * 1.4426950408889634f, bv[1] * 1.4426950408889634f); biasp[t][1] = pk2(bv[2] * 1.4426950408889634f, bv[3] * 1.4426950408889634f);
                    if ((t & 3) == 3) __builtin_amdgcn_sched_barrier(0); }
                cur_dr = dr;
            }
            const size_t rowtok = (size_t)b * SEQ + (size_t)r * 64;
            const bool has_next = (r + 1 < 64);
            const bool slide = has_next && (min(max(r + 1 - 4, 0), 56) != r0);
            const size_t new_tok = (size_t)b * SEQ + (size_t)(r0 + 8) * 64 + band0;
            f32x4 st[16];
#pragma unroll
            for (int t = 0; t < 16; ++t) st[t] = __builtin_amdgcn_mfma_f32_16x16x32_bf16(kf[t], qf, (f32x4){0.f, 0.f, 0.f, 0.f}, 0, 0, 0);
            if (has_next) qf = *(const bf16x8*)((uintptr_t)gq + ((rowtok + 64) * TOKB + qadj) + klane);
            if (slide) {
#pragma unroll
                for (int t = 0; t < 14; ++t) kf[t] = kf[t + 2];
                kf[14] = *(const bf16x8*)(gq + new_tok * TOKB + klane);
                kf[15] = *(const bf16x8*)(gq + (new_tok + 16) * TOKB + klane);
            }
            f32x2 sv[16][2]; float mx = -3e38f;
#pragma unroll
            for (int t = 0; t < 16; ++t)
#pragma unroll
                for (int hh = 0; hh < 2; ++hh) { const unsigned bw = biasp[t][hh]; const f32x2 bb = {bf_lo(bw), bf_hi(bw)}; const f32x2 a2 = {st[t][2 * hh], st[t][2 * hh + 1]};
                    sv[t][hh] = a2 * (0.17677669529663687f * 1.4426950408889634f) + bb; }
#pragma unroll
            for (int t = 0; t < 16; ++t) { mx = fmaxf(fmaxf(mx, sv[t][0][0]), sv[t][0][1]); mx = fmaxf(fmaxf(mx, sv[t][1][0]), sv[t][1][1]); }
            mx = fmaxf(mx, __shfl_xor(mx, 16)); mx = fmaxf(mx, __shfl_xor(mx, 32));
            f32x2 l2 = {0.f, 0.f}; const f32x2 nmx = {-mx, -mx};
#pragma unroll
            for (int t = 0; t < 16; ++t)
#pragma unroll
                for (int hh = 0; hh < 2; ++hh) { const f32x2 dlt = sv[t][hh] + nmx; f32x2 pj; pj[0] = exp2f_(dlt[0]); pj[1] = exp2f_(dlt[1]); sv[t][hh] = pj; l2 = l2 + pj; }
            float l = l2[0] + l2[1];
            l += __shfl_xor(l, 16); l += __shfl_xor(l, 32);
            if (slide) asm volatile("s_waitcnt vmcnt(3)" ::: "memory"); else if (has_next) asm volatile("s_waitcnt vmcnt(1)" ::: "memory"); else asm volatile("s_waitcnt vmcnt(0)" ::: "memory");
            f32x4 ot[2] = {(f32x4){0.f, 0.f, 0.f, 0.f}, (f32x4){0.f, 0.f, 0.f, 0.f}};
#pragma unroll
            for (int ks = 0; ks < 8; ++ks) {
                union { bf16x8 v; unsigned u[4]; } pb;
                pb.u[0] = pk2(sv[2 * ks][0][0], sv[2 * ks][0][1]); pb.u[1] = pk2(sv[2 * ks][1][0], sv[2 * ks][1][1]);
                pb.u[2] = pk2(sv[2 * ks + 1][0][0], sv[2 * ks + 1][0][1]); pb.u[3] = pk2(sv[2 * ks + 1][1][0], sv[2 * ks + 1][1][1]);
                const int slot = (ks + rot) & 7;
                const LAS bf16_t* vrow = Vs + (slot * 32 + quad * 4 + (li >> 2)) * 32 + (li & 3) * 4;
#pragma unroll
                for (int mt = 0; mt < 2; ++mt) {
                    const s16x4 a0 = __builtin_amdgcn_ds_read_tr16_b64_v4i16((LAS s16x4*)(vrow + mt * 16));
                    const s16x4 a1 = __builtin_amdgcn_ds_read_tr16_b64_v4i16((LAS s16x4*)(vrow + 16 * 32 + mt * 16));
                    const bf16x8 av = {a0[0], a0[1], a0[2], a0[3], a1[0], a1[1], a1[2], a1[3]};
                    ot[mt] = __builtin_amdgcn_mfma_f32_16x16x32_bf16(av, pb.v, ot[mt], 0, 0, 0);
                }
                if (ks & 1) __builtin_amdgcn_sched_barrier(0);
            }
            asm volatile("s_waitcnt lgkmcnt(0)" ::: "memory");
            const float inv = rcpf_(l);
#pragma unroll
            for (int mt = 0; mt < 2; ++mt) { u32x2 w; w.x = pk2(ot[mt][0] * inv, ot[mt][1] * inv); w.y = pk2(ot[mt][2] * inv, ot[mt][3] * inv);
                *(u32x2*)(gm + rowtok * (DM * 2) + olane + mt * 32) = w; }
            if (slide) {
#pragma unroll
                for (int hf = 0; hf < 2; ++hf)
                    __builtin_amdgcn_global_load_lds((const unsigned*)(gq + (new_tok + hf * 16) * TOKB + vlane), (LAS unsigned*)(Vs + (rot * 2 + hf) * 512), 16, 0, 0);
                rot = (rot + 1) & 7;
            }
        }
        asm volatile("s_waitcnt vmcnt(0)" ::: "memory");
    }
}

#define XB_TMO      128
#define XB_XCNT(j)  (256  + 64 * (j))
#define XB_XSUB(j)  (1280 + 64 * (j))
#define XB_XGEN(j)  (2304 + 64 * (j))
#define XB_TOP      3328
#define XB_TOPGEN   3392
#define XCD_BAR_WORDS 3456
#define XB_SPIN_CAP (1u << 18)
__device__ __forceinline__ unsigned xb_ld(unsigned* p)              { return __hip_atomic_load(p, __ATOMIC_RELAXED, __HIP_MEMORY_SCOPE_AGENT); }
__device__ __forceinline__ unsigned xb_add(unsigned* p, unsigned v) { return __hip_atomic_fetch_add(p, v, __ATOMIC_RELAXED, __HIP_MEMORY_SCOPE_AGENT); }
__device__ __forceinline__ unsigned xb_xcc_id() { return (unsigned)__builtin_amdgcn_s_getreg((3 << 11) | 20) & 0xFu; }
#define XB_SPIN(cond, bar) do { unsigned _sp = 0; while (cond) { __builtin_amdgcn_s_sleep(1); \
    if ((++_sp & 255u) == 0u) { if (xb_ld(&(bar)[XB_TMO])) break; if (_sp > XB_SPIN_CAP) { atomicAdd(&(bar)[XB_TMO], 1u); break; } } } } while (0)
struct XcdBarrier { unsigned* bar; unsigned x; volatile LAS unsigned* st; int wv; };
__device__ __forceinline__ XcdBarrier xcd_barrier_post(unsigned* bar, volatile LAS unsigned* st, const int wv) {
    XcdBarrier b; b.bar = bar; b.x = xb_xcc_id(); b.st = st; b.wv = wv;
    if (wv == 0 && lane_id() == 0) (void)xb_add(&bar[XB_XCNT(b.x)], 1u);
    return b;
}
__device__ __forceinline__ void xcd_barrier_complete(unsigned* bar, unsigned x, unsigned& nloc, unsigned& nx) {
    const unsigned G = gridDim.x * gridDim.y * gridDim.z;
    unsigned sum, cnt, mine, sp = 0u;
    for (;;) {
        sum = 0u; cnt = 0u; mine = 0u;
#pragma unroll
        for (unsigned j = 0; j < 16; ++j) { const unsigned c = xb_ld(&bar[XB_XCNT(j)]); sum += c; cnt += (c > 0u) ? 1u : 0u; mine = (j == x) ? c : mine; }
        if (sum == G) break;
        __builtin_amdgcn_s_sleep(1);
        if ((++sp & 255u) == 0u) { if (xb_ld(&bar[XB_TMO])) break; if (sp > XB_SPIN_CAP) { atomicAdd(&bar[XB_TMO], 1u); break; } }
    }
    nloc = mine > 0u ? mine : 1u; nx = cnt > 0u ? cnt : 1u;
}
__device__ __forceinline__ void xcd_barrier(const XcdBarrier& b) {
    asm volatile("s_waitcnt vmcnt(0)" ::: "memory");
    __syncthreads();
    if (b.wv == 0 && lane_id() == 0) {
        unsigned* bar = b.bar;
        __builtin_amdgcn_s_waitcnt(0);
        unsigned nloc = b.st[0], nx = b.st[1];
        if (nloc == 0u) { xcd_barrier_complete(bar, b.x, nloc, nx); b.st[0] = nloc; b.st[1] = nx; }
        const unsigned old = xb_add(&bar[XB_XSUB(b.x)], 1u);
        const unsigned gen = old / nloc;
        if (old + 1u == (gen + 1u) * nloc) {
            __builtin_amdgcn_fence(__ATOMIC_RELEASE, "agent");
            asm volatile("s_waitcnt vmcnt(0)" ::: "memory");
            const unsigned og = xb_add(&bar[XB_TOP], 1u);
            const unsigned tg = og / nx;
            if (og + 1u == (tg + 1u) * nx) xb_add(&bar[XB_TOPGEN], 1u);
            else XB_SPIN(xb_ld(&bar[XB_TOPGEN]) == tg, bar);
            __builtin_amdgcn_fence(__ATOMIC_ACQUIRE, "agent");
            xb_add(&bar[XB_XGEN(b.x)], 1u);
            asm volatile("s_waitcnt vmcnt(0)" ::: "memory");
        } else {
            XB_SPIN(xb_ld(&bar[XB_XGEN(b.x)]) == gen, bar);
            __builtin_amdgcn_fence(__ATOMIC_ACQUIRE, "agent");
            asm volatile("s_waitcnt vmcnt(0)" ::: "memory");
        }
    }
    __syncthreads();
}

__global__ void __launch_bounds__(512, 2) mega_fwd(Params p) {
    extern __shared__ __attribute__((aligned(16))) unsigned char shm[];
    LAS unsigned char* lds = (LAS unsigned char*)shm;
    cg::grid_group grid = cg::this_grid();
    bf16_t* WT = (bf16_t*)(p.ws + WS_WT); bf16_t* HB = (bf16_t*)(p.ws + WS_HB); bf16_t* PROJ = (bf16_t*)(p.ws + WS_PROJ); bf16_t* MIX = (bf16_t*)(p.ws + WS_MIX);
    unsigned short* R16 = (unsigned short*)((char*)p.out + (size_t)NTOK * DM * 2);
    const int wv = __builtin_amdgcn_readfirstlane((int)(threadIdx.x >> 6));
    volatile LAS unsigned* xbst = (volatile LAS unsigned*)(lds + 131072);
    if (wv == 0 && lane_id() == 0) { xbst[0] = 0u; xbst[1] = 0u; xbst[2] = 0u; xbst[3] = 0u; }
    __syncthreads();
    const XcdBarrier xb = xcd_barrier_post((unsigned*)(p.ws + WS_BAR), xbst, wv);
    p0_phase(p, lds, wv);
    grid.sync();
    for (int l = 0; l < 4; ++l) {
        const int j = l >> 1; const bool even = (l & 1) == 0; const bf16_t* wl = WT + (size_t)l * LAYER_W_ELEMS;
        {
            const int N = even ? INP : QKVN;
            pg8::StaticOrder S; S.init(NTOK, N, (int)gridDim.x, (int)blockIdx.x);
            pg8::EpiStoreBf16 E; E.O = PROJ; E.ldc = N;
            pg8::Gemm g; g.A = HB; g.Bt = wl; g.M = NTOK; g.N = N; g.K = DM;
            pg8::gemm_phase(lds, g, S, E, wv);
        }
        xcd_barrier(xb);
        if (even) {
            conv_phase(p, j, wv);
            xcd_barrier(xb);
            scan_phase(p, j, lds, wv);
            xcd_barrier(xb);
            combine_phase(p, j, wv);
        } else {
            na_phase(p, j, lds, wv);
        }
        xcd_barrier(xb);
        gemm_ln_phase(lds, MIX, wl + OFF_WOUT, DM, (unsigned short*)p.out, p.out, HB, R16, p.in[11] + l * DM, p.in[12] + l * DM, false, wv);
        xcd_barrier(xb);
        {
            pg8::StaticOrder S; S.init(NTOK, GUN, (int)gridDim.x, (int)blockIdx.x);
            pg8::EpiSwiglu E; E.O = PROJ; E.ldc = FF;
            pg8::Gemm g; g.A = HB; g.Bt = wl + OFF_WGU; g.M = NTOK; g.N = GUN; g.K = DM;
            pg8::gemm_phase(lds, g, S, E, wv);
        }
        xcd_barrier(xb);
        gemm_ln_phase(lds, PROJ, wl + OFF_WD, FF, (unsigned short*)MIX, p.out, HB, R16, p.in[13] + l * DM, p.in[14] + l * DM, l == 3, wv);
        xcd_barrier(xb);
    }
}

extern "C" void kernel_launch(void* const* d_in, const int* in_sizes, int n_in, void* d_out, int out_size, void* d_ws, size_t ws_size, hipStream_t stream) {
    static int grid_blocks = 0;
    if (grid_blocks == 0) {
        if (n_in != 18 || out_size != NTOK * DM || ws_size < WS_TOTAL) { fprintf(stderr, "kernel_launch: unexpected problem (n_in %d out %d ws %zu need %zu)\n", n_in, out_size, ws_size, (size_t)WS_TOTAL); grid_blocks = -1; return; }
        int dev = 0, cus = 0, per_cu = 0;
        hipGetDevice(&dev);
        hipDeviceGetAttribute(&cus, hipDeviceAttributeMultiprocessorCount, dev);
        if (hipFuncSetAttribute((const void*)mega_fwd, hipFuncAttributeMaxDynamicSharedMemorySize, LDS_BYTES) != hipSuccess) { fprintf(stderr, "kernel_launch: hipFuncSetAttribute failed\n"); }
        if (hipOccupancyMaxActiveBlocksPerMultiprocessor(&per_cu, (const void*)mega_fwd, 512, LDS_BYTES) != hipSuccess || per_cu < 1) { fprintf(stderr, "kernel_launch: occupancy query gives %d\n", per_cu); per_cu = 1; }
        (void)hipGetLastError();
        grid_blocks = cus * per_cu;
    }
    if (grid_blocks < 0) return;
    if (hipMemsetAsync((char*)d_ws + WS_BAR, 0, XCD_BAR_WORDS * 4, stream) != hipSuccess) { fprintf(stderr, "kernel_launch: memset of barrier words failed\n"); return; }
    Params p{};
    for (int i = 0; i < 18; ++i) p.in[i] = (const float*)d_in[i];
    p.out = (float*)d_out; p.ws = (unsigned char*)d_ws;
    void* args[] = {&p};
    hipError_t e = hipLaunchCooperativeKernel((const void*)mega_fwd, dim3(grid_blocks), dim3(512), args, LDS_BYTES, stream);
    if (e != hipSuccess) fprintf(stderr, "cooperative launch failed: %s (grid %d)\n", hipGetErrorString(e), grid_blocks);
}
```

```cpp
#include <hip/hip_runtime.h>
#include <hip/hip_cooperative_groups.h>
#include <cstdio>
#include <cstdint>
namespace cg = cooperative_groups;

#define LAS __attribute__((address_space(3)))
typedef unsigned short bf16_t;
typedef short bf16x8 __attribute__((ext_vector_type(8)));
typedef float f32x4 __attribute__((ext_vector_type(4)));
typedef unsigned u32x4 __attribute__((ext_vector_type(4)));
typedef unsigned u32x2 __attribute__((ext_vector_type(2)));
typedef short s16x4 __attribute__((ext_vector_type(4)));

constexpr int SEQ = 4096, DM = 1024, NTOK = 65536, NPANEL = 256;
constexpr int INC = 4624, INP = 4864, QKVN = 3072, FF = 2816, GUN = 5632;
constexpr int C_AQ = 0, C_AFF = 512, C_AFB = 1024, C_AI = 1536, C_AG = 2048, C_BQ = 2560, C_BK = 3072, C_BV = 3584, C_BO = 4096, C_BG = 4608;
constexpr float ALPHA = 1.681792830507429f;
constexpr float LN_EPS = 1e-5f, GN_EPS = 1e-6f;
constexpr size_t W_IN_ELEMS = (size_t)INP * DM, W_OUT_ELEMS = (size_t)DM * DM, W_GU_ELEMS = (size_t)GUN * DM, W_D_ELEMS = (size_t)DM * FF;
constexpr size_t OFF_WOUT = W_IN_ELEMS, OFF_WGU = OFF_WOUT + W_OUT_ELEMS, OFF_WD = OFF_WGU + W_GU_ELEMS, LAYER_W_ELEMS = OFF_WD + W_D_ELEMS;
constexpr size_t WS_WT = 0, WS_HB = WS_WT + 4 * LAYER_W_ELEMS * 2, WS_PROJ = WS_HB + (size_t)NTOK * DM * 2, WS_MIX = WS_PROJ + (size_t)NTOK * INP * 2, WS_END = WS_MIX + (size_t)NTOK * DM * 2;
constexpr size_t WS_BAR = WS_END, WS_TOTAL = WS_BAR + 16384;
constexpr int LDS_BYTES = 131072 + 16;

struct Params {
    const float* in[18];
    float* out;
    unsigned char* ws;
};

typedef float f32x2 __attribute__((ext_vector_type(2)));
typedef __bf16 bf16x2v __attribute__((ext_vector_type(2)));
__device__ __forceinline__ unsigned pk2(float lo, float hi) { const f32x2 f = {lo, hi}; const bf16x2v b = __builtin_convertvector(f, bf16x2v); return __builtin_bit_cast(unsigned, b); }
__device__ __forceinline__ float bf_lo(unsigned u) { return __uint_as_float(u << 16); }
__device__ __forceinline__ float bf_hi(unsigned u) { return __uint_as_float(u & 0xffff0000u); }
typedef _Float16 f16x2v __attribute__((ext_vector_type(2)));
__device__ __forceinline__ unsigned pkh2(float lo, float hi) { const f32x2 f = {lo, hi}; const f16x2v h = __builtin_convertvector(f, f16x2v); return __builtin_bit_cast(unsigned, h); }
__device__ __forceinline__ float h_lo(unsigned u) { const f16x2v h = __builtin_bit_cast(f16x2v, u); return (float)h[0]; }
__device__ __forceinline__ float h_hi(unsigned u) { const f16x2v h = __builtin_bit_cast(f16x2v, u); return (float)h[1]; }
__device__ __forceinline__ float bf1(bf16_t b) { return __uint_as_float(((unsigned)b) << 16); }
__device__ __forceinline__ float logf_(float x) { return __builtin_amdgcn_logf(x) * 0.6931471805599453f; }
__device__ __forceinline__ float rcpf_(float x) { return __builtin_amdgcn_rcpf(x); }
__device__ __forceinline__ float sigmoidf_(float x) { return rcpf_(1.0f + __expf(-x)); }
__device__ __forceinline__ float siluf_(float x) { return x * rcpf_(1.0f + __expf(-x)); }
__device__ __forceinline__ int lane_id() { int l; asm volatile("v_mbcnt_lo_u32_b32 %0, -1, 0\n\tv_mbcnt_hi_u32_b32 %0, -1, %0" : "=v"(l)); return l; }
__device__ __forceinline__ int tid_fresh(int wv) { int t = wv * 64 + lane_id(); asm volatile("" : "+v"(t)); return t; }
__device__ __forceinline__ float wave_sum(float v) {
#pragma unroll
    for (int o = 1; o < 64; o <<= 1) v += __shfl_xor(v, o);
    return v;
}

namespace pg8 {
constexpr int BM = 256, BK = 64, HALF = 128, HTB = HALF * BK * 2, NXCD = 8, WGM = 8;
__device__ __forceinline__ int lds_byte(int r, int c) { const int st = (r >> 4) * 2 + (c >> 5), rr = r & 15, cc = c & 31, ob = rr * 64 + cc * 2; return st * 1024 + (ob ^ (((ob >> 9) & 1) << 5)); }
__device__ __forceinline__ void stage_rc(int b, int& R, int& C) { const int st = b / 1024, sb = b % 1024, swz = sb ^ (((sb >> 9) & 1) << 5); R = (st >> 1) * 16 + swz / 64; C = (st & 1) * 32 + (swz % 64) / 2; }
__device__ __forceinline__ int perm32(int rho) { const int n = rho >> 4, i = rho & 15; return 8 * (i >> 2) + 4 * n + (i & 3); }
struct Unit { int pm, pn; };
struct Gemm { const bf16_t* A; const bf16_t* Bt; int M, N, K; };
struct StaticOrder {
    int nM, nN, nwg, G, c;
    __device__ void init(int M, int N, int G_, int c_) { nM = M / BM; nN = N / BM; nwg = nM * nN; G = G_; c = c_; }
    __device__ bool next(int i, Unit& u) const {
        const long L = (long)i * G + c; if (L >= nwg) return false;
        int wgid = (int)L; { const int q = nwg / NXCD, r = nwg % NXCD, xcd = wgid % NXCD, off = wgid / NXCD; wgid = (xcd < r ? xcd * (q + 1) : r * (q + 1) + (xcd - r) * q) + off; }
        const int nig = WGM * nN, gid = wgid / nig, fm = gid * WGM, gsz = (nM - fm) < WGM ? (nM - fm) : WGM;
        u.pm = fm + ((wgid % nig) % gsz); u.pn = (wgid % nig) / gsz; return true;
    }
};
struct PanelOrder {
    int pm, nN;
    __device__ bool next(int i, Unit& u) const { if (i >= nN) return false; u.pm = pm; u.pn = i; return true; }
};
struct EpiStoreBf16 {
    static constexpr bool PERM = true, ALIGN = true;
    bf16_t* O; int ldc;
    __device__ __forceinline__ void operator()(const f32x4 (&acc)[2][2][4][2], const Unit& u, int wr, int wc, int fr, int fq) const {
        const int row0 = u.pm * BM + wr * 64 + fr, col0 = u.pn * BM + wc * 32 + 8 * fq;
#pragma unroll
        for (int ai = 0; ai < 2; ++ai)
#pragma unroll
            for (int m = 0; m < 4; ++m) { bf16_t* rowp = O + (size_t)(row0 + ai * HALF + m * 16) * ldc + col0;
#pragma unroll
                for (int bj = 0; bj < 2; ++bj) { const f32x4 v0 = acc[ai][bj][m][0], v1 = acc[ai][bj][m][1];
                    u32x4 w; w.x = pk2(v0[0], v0[1]); w.y = pk2(v0[2], v0[3]); w.z = pk2(v1[0], v1[1]); w.w = pk2(v1[2], v1[3]);
                    *(u32x4*)(rowp + bj * HALF) = w; }
                asm volatile("" ::: "memory"); }
    }
};
struct EpiSwiglu {
    static constexpr bool PERM = true, ALIGN = true;
    bf16_t* O; int ldc;
    __device__ __forceinline__ void operator()(const f32x4 (&acc)[2][2][4][2], const Unit& u, int wr, int wc, int fr, int fq) const {
        const int row0 = u.pm * BM + wr * 64 + fr, col0 = u.pn * HALF + wc * 32 + 8 * fq;
#pragma unroll
        for (int ai = 0; ai < 2; ++ai)
#pragma unroll
            for (int m = 0; m < 4; ++m) { bf16_t* rowp = O + (size_t)(row0 + ai * HALF + m * 16) * ldc + col0;
                float hv[8];
#pragma unroll
                for (int n = 0; n < 2; ++n)
#pragma unroll
                    for (int jj = 0; jj < 4; ++jj) { const float g = acc[ai][0][m][n][jj], uu = acc[ai][1][m][n][jj]; hv[n * 4 + jj] = siluf_(g) * uu; }
                u32x4 w; w.x = pk2(hv[0], hv[1]); w.y = pk2(hv[2], hv[3]); w.z = pk2(hv[4], hv[5]); w.w = pk2(hv[6], hv[7]);
                *(u32x4*)rowp = w;
                asm volatile("" ::: "memory"); }
    }
};
struct EpiResid {
    static constexpr bool PERM = false, ALIGN = false;
    unsigned short* Y; const unsigned short* R; float alpha; bool res_bf16;
    __device__ __forceinline__ void operator()(const f32x4 (&acc)[2][2][4][2], const Unit& u, int wr, int wc, int fr, int fq) const {
        const int row0 = u.pm * BM + wr * 64 + fr, col0 = u.pn * BM + wc * 32 + 4 * fq;
        const size_t off0 = (size_t)row0 * DM + col0;
        u32x2 hv[2][4][2][2];
#pragma unroll
        for (int ai = 0; ai < 2; ++ai)
#pragma unroll
            for (int m = 0; m < 4; ++m)
#pragma unroll
                for (int bj = 0; bj < 2; ++bj)
#pragma unroll
                    for (int n = 0; n < 2; ++n) hv[ai][m][bj][n] = *(const u32x2*)(R + off0 + (size_t)(ai * HALF + m * 16) * DM + bj * HALF + n * 16);
#pragma unroll
        for (int ai = 0; ai < 2; ++ai)
#pragma unroll
            for (int m = 0; m < 4; ++m)
#pragma unroll
                for (int bj = 0; bj < 2; ++bj)
#pragma unroll
                    for (int n = 0; n < 2; ++n) { const u32x2 w = hv[ai][m][bj][n];
                        const f32x4 r = res_bf16 ? (f32x4){bf_lo(w.x), bf_hi(w.x), bf_lo(w.y), bf_hi(w.y)} : (f32x4){h_lo(w.x), h_hi(w.x), h_lo(w.y), h_hi(w.y)};
                        const f32x4 y = r * alpha + acc[ai][bj][m][n]; u32x2 o; o.x = pkh2(y[0], y[1]); o.y = pkh2(y[2], y[3]);
                        *(u32x2*)(Y + off0 + (size_t)(ai * HALF + m * 16) * DM + bj * HALF + n * 16) = o; }
    }
};

template <class Epi, class Sched>
__device__ __forceinline__ void gemm_phase(LAS unsigned char* lds, const Gemm g, const Sched& S, const Epi& E, const int wv) {
    const int tid = tid_fresh(wv), wid = __builtin_amdgcn_readfirstlane(tid >> 6), lane = tid & 63, wr = wid >> 2, wc = wid & 3, fr = lane & 15, fq = lane >> 4;
    const int K = g.K, nt = K / BK;
    unsigned voffA[2], voffB[2];
#pragma unroll
    for (int i = 0; i < 2; ++i) { int R, C; stage_rc(tid * 16 + i * 8192, R, C); const int Rb = Epi::PERM ? ((R & ~31) + perm32(R & 31)) : R;
        voffA[i] = (unsigned)(R * K + C) * 2u; voffB[i] = (unsigned)(Rb * K + C) * 2u; }
    const size_t kstep = (size_t)(BK * 2);
    const size_t hstep = (size_t)HALF * K * 2;
    const size_t tstep = 2 * hstep;
    const unsigned ldsw = (unsigned)wid * 1024u;
    const int aoff = lds_byte(wr * 64 + fr, fq * 8), boff = lds_byte(wc * 32 + fr, fq * 8);
#define PG8_SA(b, h) (((b) * 2 + (h)) * HTB)
#define PG8_SB(b, h) ((4 + (b) * 2 + (h)) * HTB)
#define PG8_STAGE(bufoff, gbase, voff) do { _Pragma("unroll") for (int _i = 0; _i < 2; ++_i) \
        __builtin_amdgcn_global_load_lds((const unsigned*)((const char*)(gbase) + (voff)[_i]), (LAS unsigned*)(lds + (bufoff) + ldsw + _i * 8192), 16, 0, 0); } while (0)
#define PG8_LDA(dst, b, h) do { _Pragma("unroll") for (int m = 0; m < 4; ++m) _Pragma("unroll") for (int k = 0; k < 2; ++k) dst[m][k] = *(const LAS bf16x8*)(lds + PG8_SA(b, h) + aoff + m * 2048 + k * 1024); } while (0)
#define PG8_LDB(dst, b, h) do { _Pragma("unroll") for (int n = 0; n < 2; ++n) _Pragma("unroll") for (int k = 0; k < 2; ++k) dst[n][k] = *(const LAS bf16x8*)(lds + PG8_SB(b, h) + boff + n * 2048 + k * 1024); } while (0)
#define PG8_MMA(ai, bj, At, Bt) do { __builtin_amdgcn_s_setprio(1); _Pragma("unroll") for (int m = 0; m < 4; ++m) _Pragma("unroll") for (int n = 0; n < 2; ++n) _Pragma("unroll") for (int k = 0; k < 2; ++k) \
        acc[ai][bj][m][n] = __builtin_amdgcn_mfma_f32_16x16x32_bf16(Bt[n][k], At[m][k], acc[ai][bj][m][n], 0, 0, 0); __builtin_amdgcn_s_setprio(0); } while (0)
#define PG8_WAIT_V(n) asm volatile("s_waitcnt vmcnt(" #n ")" ::: "memory")
#define PG8_WAIT_L(n) asm volatile("s_waitcnt lgkmcnt(" #n ")" ::: "memory")
#define PG8_BAR __builtin_amdgcn_s_barrier()
#define PG8_SCHED __builtin_amdgcn_sched_barrier(0)
    Unit cur, nxt; int ui = 0;
    if (!S.next(0, cur)) return;
    f32x4 acc[2][2][4][2];
#pragma unroll
    for (int a = 0; a < 2; ++a)
#pragma unroll
        for (int b = 0; b < 2; ++b)
#pragma unroll
            for (int m = 0; m < 4; ++m)
#pragma unroll
                for (int n = 0; n < 2; ++n) acc[a][b][m][n] = (f32x4){0.f, 0.f, 0.f, 0.f};
    bf16x8 At[4][2], B0[2][2], B1[2][2];
    const char* cA = (const char*)g.A + (size_t)cur.pm * tstep; const char* cB = (const char*)g.Bt + (size_t)cur.pn * tstep;
    PG8_STAGE(PG8_SB(0, 0), cB, voffB); PG8_STAGE(PG8_SB(0, 1), cB + hstep, voffB); PG8_STAGE(PG8_SA(0, 0), cA, voffA); PG8_STAGE(PG8_SA(0, 1), cA + hstep, voffA);
    if (wr == 1) PG8_BAR;
    PG8_WAIT_V(2); PG8_BAR;
    PG8_STAGE(PG8_SB(1, 0), cB + kstep, voffB); PG8_STAGE(PG8_SA(1, 0), cA + kstep, voffA); PG8_STAGE(PG8_SB(1, 1), cB + hstep + kstep, voffB);
    PG8_WAIT_V(6); PG8_BAR;
    for (;;) {
        const bool has_next = S.next(ui + 1, nxt);
        const char* nA = has_next ? (const char*)g.A + (size_t)nxt.pm * tstep : cA; const char* nB = has_next ? (const char*)g.Bt + (size_t)nxt.pn * tstep : cB;
        for (int t = 0; t < nt; t += 2) {
            const bool last = (t == nt - 2);
            const char* a1 = cA + (size_t)(t + 1) * kstep;
            const char* a2 = last ? nA : cA + (size_t)(t + 2) * kstep; const char* b2 = last ? nB : cB + (size_t)(t + 2) * kstep;
            const char* a3 = a2 + kstep; const char* b3 = b2 + kstep;
            PG8_LDB(B0, 0, 0); PG8_LDB(B1, 0, 1); PG8_SCHED; PG8_LDA(At, 0, 0); PG8_STAGE(PG8_SA(1, 1), a1 + hstep, voffA);
            PG8_WAIT_V(8); PG8_WAIT_L(0); PG8_BAR; PG8_MMA(0, 0, At, B0); PG8_MMA(0, 1, At, B1); PG8_BAR; PG8_SCHED;
            PG8_LDA(At, 0, 1); PG8_STAGE(PG8_SB(0, 0), b2, voffB); PG8_STAGE(PG8_SB(0, 1), b2 + hstep, voffB); PG8_STAGE(PG8_SA(0, 0), a2, voffA);
            PG8_WAIT_V(8); PG8_WAIT_L(0); PG8_BAR; PG8_MMA(1, 0, At, B0); PG8_MMA(1, 1, At, B1); PG8_BAR; PG8_SCHED;
            PG8_LDB(B0, 1, 0); PG8_LDB(B1, 1, 1); PG8_SCHED; PG8_LDA(At, 1, 0); PG8_STAGE(PG8_SA(0, 1), a2 + hstep, voffA);
            PG8_WAIT_V(8); PG8_WAIT_L(0); PG8_BAR; PG8_MMA(0, 0, At, B0); PG8_MMA(0, 1, At, B1); PG8_BAR; PG8_SCHED;
            PG8_LDA(At, 1, 1); PG8_STAGE(PG8_SB(1, 0), b3, voffB); PG8_STAGE(PG8_SB(1, 1), b3 + hstep, voffB); PG8_STAGE(PG8_SA(1, 0), a3, voffA);
            PG8_WAIT_V(8); PG8_WAIT_L(0); PG8_BAR; PG8_MMA(1, 0, At, B0); PG8_MMA(1, 1, At, B1); PG8_BAR; PG8_SCHED;
        }
        if (Epi::ALIGN) { if (wr == 0) PG8_BAR; }
        E(acc, cur, wr, wc, fr, fq);
        if (!has_next) break;
#pragma unroll
        for (int a = 0; a < 2; ++a)
#pragma unroll
            for (int b = 0; b < 2; ++b)
#pragma unroll
                for (int m = 0; m < 4; ++m)
#pragma unroll
                    for (int n = 0; n < 2; ++n) acc[a][b][m][n] = (f32x4){0.f, 0.f, 0.f, 0.f};
        cur = nxt; cA = nA; cB = nB; ++ui;
        if (Epi::ALIGN) { if (wr == 1) PG8_BAR; }
    }
    PG8_WAIT_V(0);
    if (!Epi::ALIGN) { if (wr == 0) PG8_BAR; }
    PG8_BAR;
#undef PG8_SA
#undef PG8_SB
#undef PG8_STAGE
#undef PG8_LDA
#undef PG8_LDB
#undef PG8_MMA
#undef PG8_WAIT_V
#undef PG8_WAIT_L
#undef PG8_BAR
#undef PG8_SCHED
}
}

__device__ __forceinline__ void tr_item(const float* W, int ldw, int colbase, int nvalid, bf16_t* dst, int K, int n0, int k0, LAS float* scr, int lane) {
#pragma unroll 16
    for (int i = 0; i < 32; ++i) { const int kk = 2 * i + (lane >> 5), c = lane & 31;
        scr[kk * 33 + c] = (c < nvalid) ? W[(size_t)(k0 + kk) * ldw + colbase + c] : 0.0f; }
    asm volatile("s_waitcnt lgkmcnt(0)" ::: "memory");
    const int c = lane & 7;
#pragma unroll
    for (int j = 0; j < 4; ++j) { const int n = (lane >> 3) + 8 * j; const LAS float* s = scr + (8 * c) * 33 + n;
        u32x4 o; o.x = pk2(s[0 * 33], s[1 * 33]); o.y = pk2(s[2 * 33], s[3 * 33]); o.z = pk2(s[4 * 33], s[5 * 33]); o.w = pk2(s[6 * 33], s[7 * 33]);
        *(u32x4*)(dst + (size_t)(n0 + n) * K + k0 + 8 * c) = o; }
    asm volatile("s_waitcnt lgkmcnt(0)" ::: "memory");
}
__device__ __forceinline__ void tr_plain(const float* W, int ldw, int nsrc, int K, bf16_t* dst, int ndst, LAS float* scr, int lane, int gw, int NGW, int& base) {
    const int nblk = ndst / 32, nitems = nblk * (K / 64);
    const int first = ((gw - (base % NGW)) % NGW + NGW) % NGW;
    for (int it = first; it < nitems; it += NGW) { const int kb = it / nblk, nb = it % nblk, n0 = nb * 32;
        tr_item(W, ldw, n0, nsrc - n0, dst, K, n0, kb * 64, scr, lane); }
    base += nitems;
}
__device__ __forceinline__ void tr_gu(const float* Wg, const float* Wu, bf16_t* dst, LAS float* scr, int lane, int gw, int NGW, int& base) {
    const int nblk = GUN / 32, nitems = nblk * (DM / 64);
    const int first = ((gw - (base % NGW)) % NGW + NGW) % NGW;
    for (int it = first; it < nitems; it += NGW) { const int kb = it / nblk, nb = it % nblk, n0 = nb * 32;
        const int q = n0 >> 7, tile = q >> 1, isup = q & 1;
        tr_item(isup ? Wu : Wg, FF, tile * 128 + (n0 & 127), 32, dst, DM, n0, kb * 64, scr, lane); }
    base += nitems;
}
__device__ __forceinline__ void p0_phase(const Params& p, LAS unsigned char* lds, const int wv) {
    const int tid = tid_fresh(wv), wave = tid >> 6, lane = tid & 63;
    const int gw = blockIdx.x * 8 + wave, NGW = gridDim.x * 8;
    LAS float* scr = (LAS float*)(lds + wave * 16384);
    bf16_t* WT = (bf16_t*)(p.ws + WS_WT);
    int base = 0;
    for (int l = 0; l < 4; ++l) { const int j = l >> 1; bf16_t* wl = WT + (size_t)l * LAYER_W_ELEMS;
        if ((l & 1) == 0) {
            tr_plain(p.in[1] + (size_t)j * DM * INC, INC, INC, DM, wl, INP, scr, lane, gw, NGW, base);
            tr_plain(p.in[7] + (size_t)j * DM * DM, DM, DM, DM, wl + OFF_WOUT, DM, scr, lane, gw, NGW, base);
        } else {
            tr_plain(p.in[8] + (size_t)j * DM * QKVN, QKVN, QKVN, DM, wl, QKVN, scr, lane, gw, NGW, base);
            tr_plain(p.in[10] + (size_t)j * DM * DM, DM, DM, DM, wl + OFF_WOUT, DM, scr, lane, gw, NGW, base);
        }
        tr_gu(p.in[15] + (size_t)l * DM * FF, p.in[16] + (size_t)l * DM * FF, wl + OFF_WGU, scr, lane, gw, NGW, base);
        tr_plain(p.in[17] + (size_t)l * FF * DM, DM, DM, FF, wl + OFF_WD, DM, scr, lane, gw, NGW, base);
    }
    const f32x4* x4 = (const f32x4*)p.in[0]; u32x2* hb2 = (u32x2*)(p.ws + WS_HB); u32x2* r2 = (u32x2*)((char*)p.out + (size_t)NTOK * DM * 2);
    const size_t n4 = (size_t)NTOK * DM / 4;
    const size_t stride = (size_t)gridDim.x * 512;
    for (size_t i = (size_t)blockIdx.x * 512 + tid; i < n4; i += 4 * stride) {
        f32x4 v[4];
#pragma unroll
        for (int q = 0; q < 4; ++q) v[q] = (i + q * stride < n4) ? x4[i + q * stride] : (f32x4){0.f, 0.f, 0.f, 0.f};
#pragma unroll
        for (int q = 0; q < 4; ++q) if (i + q * stride < n4) { u32x2 o; o.x = pk2(v[q][0], v[q][1]); o.y = pk2(v[q][2], v[q][3]); hb2[i + q * stride] = o; u32x2 r; r.x = pkh2(v[q][0], v[q][1]); r.y = pkh2(v[q][2], v[q][3]); r2[i + q * stride] = r; }
    }
}

__device__ __forceinline__ void ln_panel(const unsigned short* Y, float* OUT, bf16_t* HB, unsigned short* R16, const float* gam, const float* bet, int pm, const bool last, const int wv) {
    const int tid = tid_fresh(wv), wave = tid >> 6, lane = tid & 63;
    f32x4 gv[4], bv[4];
#pragma unroll
    for (int j = 0; j < 4; ++j) { gv[j] = ((const f32x4*)gam)[lane + 64 * j]; bv[j] = ((const f32x4*)bet)[lane + 64 * j]; }
#pragma unroll 1
    for (int rg = 0; rg < 4; ++rg) { const size_t row0 = (size_t)pm * 256 + wave * 32 + rg * 8;
        u32x2 raw[8][4];
#pragma unroll
        for (int q = 0; q < 8; ++q)
#pragma unroll
            for (int j = 0; j < 4; ++j) raw[q][j] = ((const u32x2*)(Y + (row0 + q) * DM))[lane + 64 * j];
#pragma unroll
        for (int q = 0; q < 8; ++q) {
            f32x4 v[4]; float s = 0.f;
#pragma unroll
            for (int j = 0; j < 4; ++j) { v[j] = (f32x4){h_lo(raw[q][j].x), h_hi(raw[q][j].x), h_lo(raw[q][j].y), h_hi(raw[q][j].y)}; s += (v[j][0] + v[j][1]) + (v[j][2] + v[j][3]); }
            const float mean = wave_sum(s) * (1.f / DM); float s2 = 0.f;
#pragma unroll
            for (int j = 0; j < 4; ++j) { v[j] = v[j] - mean; s2 += (v[j][0] * v[j][0] + v[j][1] * v[j][1]) + (v[j][2] * v[j][2] + v[j][3] * v[j][3]); }
            const float rstd = 1.0f / sqrtf(wave_sum(s2) * (1.f / DM) + LN_EPS);
            f32x4* xr = (f32x4*)(OUT + (row0 + q) * DM) + lane; u32x2* o8 = (u32x2*)(HB + (row0 + q) * DM) + lane; u32x2* r8 = (u32x2*)(R16 + (row0 + q) * DM) + lane;
#pragma unroll
            for (int j = 0; j < 4; ++j) { const f32x4 y = v[j] * rstd * gv[j] + bv[j];
                if (last) xr[64 * j] = y;
                else { u32x2 o; o.x = pk2(y[0], y[1]); o.y = pk2(y[2], y[3]); o8[64 * j] = o; u32x2 r; r.x = pkh2(y[0], y[1]); r.y = pkh2(y[2], y[3]); r8[64 * j] = r; } }
        }
    }
}
__device__ __forceinline__ void gemm_ln_phase(LAS unsigned char* lds, const bf16_t* A, const bf16_t* Bt, int K, unsigned short* Y, float* OUT, bf16_t* HB, unsigned short* R16, const float* gam, const float* bet, const bool last, const int wv) {
    for (int pm = blockIdx.x; pm < NPANEL; pm += gridDim.x) {
        pg8::PanelOrder S; S.pm = pm; S.nN = 4;
        pg8::EpiResid E; E.Y = Y; E.R = last ? (const unsigned short*)HB : (const unsigned short*)R16; E.alpha = ALPHA; E.res_bf16 = last;
        pg8::Gemm g; g.A = A; g.Bt = Bt; g.M = NTOK; g.N = DM; g.K = K;
        pg8::gemm_phase(lds, g, S, E, wv);
        __syncthreads();
        ln_panel(Y, OUT, HB, R16, gam, bet, pm, last, wv);
        __syncthreads();
    }
}

__device__ __forceinline__ void conv_phase(const Params& p, int j, const int wv) {
    const bf16_t* proj = (const bf16_t*)(p.ws + WS_PROJ); bf16_t* mix = (bf16_t*)(p.ws + WS_MIX);
    const float* cw = p.in[4] + (size_t)j * 5 * DM;
    const size_t total = (size_t)NTOK * 128, stride = (size_t)gridDim.x * 512;
    const int tid = tid_fresh(wv);
    const int c = (tid & 127) * 8;
    f32x4 w0[5], w1[5];
#pragma unroll
    for (int jj = 0; jj < 5; ++jj) { w0[jj] = *(const f32x4*)(cw + jj * DM + c); w1[jj] = *(const f32x4*)(cw + jj * DM + c + 4); }
    const float sc = (c >= 512) ? 0.08838834764831845f : 1.0f;
    for (size_t idx = (size_t)blockIdx.x * 512 + tid; idx < total; idx += 2 * stride) {
        u32x4 xv[2][5];
#pragma unroll
        for (int q = 0; q < 2; ++q) { const size_t id = idx + q * stride; const int tok = (int)(id >> 7), t = tok & (SEQ - 1);
#pragma unroll
            for (int jj = 0; jj < 5; ++jj) { const int tt = t + jj - 2;
                xv[q][jj] = (id < total && tt >= 0 && tt < SEQ) ? *(const u32x4*)(proj + (size_t)(tok + jj - 2) * INP + C_BQ + c) : (u32x4){0u, 0u, 0u, 0u}; } }
#pragma unroll
        for (int q = 0; q < 2; ++q) { const size_t id = idx + q * stride; if (id >= total) break; const int tok = (int)(id >> 7);
            float a[8];
#pragma unroll
            for (int i = 0; i < 8; ++i) a[i] = 0.f;
#pragma unroll
            for (int jj = 0; jj < 5; ++jj) { const u32x4 x = xv[q][jj];
                a[0] += bf_lo(x.x) * w0[jj][0]; a[1] += bf_hi(x.x) * w0[jj][1]; a[2] += bf_lo(x.y) * w0[jj][2]; a[3] += bf_hi(x.y) * w0[jj][3];
                a[4] += bf_lo(x.z) * w1[jj][0]; a[5] += bf_hi(x.z) * w1[jj][1]; a[6] += bf_lo(x.w) * w1[jj][2]; a[7] += bf_hi(x.w) * w1[jj][3]; }
#pragma unroll
            for (int i = 0; i < 8; ++i) a[i] = siluf_(a[i]) * sc;
            u32x4 o; o.x = pk2(a[0], a[1]); o.y = pk2(a[2], a[3]); o.z = pk2(a[4], a[5]); o.w = pk2(a[6], a[7]);
            *(u32x4*)(mix + (size_t)tok * DM + c) = o; }
    }
}

template <bool ML>
__device__ __forceinline__ void chunk_scan(const Params& p, int j, int b, int h, int dir, LAS unsigned char* lds, const int wv) {
    constexpr int RS = 136, RT = 144, NCH = SEQ / 32;
    constexpr int BUF = (32 * RS * 2 + 32 * RT * 2) * 2 + 512;
    bf16_t* proj = (bf16_t*)(p.ws + WS_PROJ); const bf16_t* mix = (const bf16_t*)(p.ws + WS_MIX);
    const size_t rowbase = (size_t)b * SEQ;
    const int zc = (dir ? C_AFB : C_AFF) + h * 128;
    const int ocol = ML ? ((dir ? C_BK : C_BQ) + h * 128) : zc;
    if (wv >= 4) {
        const int gtid = tid_fresh(wv) - 256, dp = gtid >> 2, tq = gtid & 3, d = 2 * dp, vs_s = gtid >> 4, vs_c = (gtid & 15) * 8;
        float lb[2] = {0.f, 0.f}, oml[2] = {1.f, 1.f}, bi = 0.f, bff = 0.f;
        if (ML) { bi = p.in[2][j * 16 + dir * 4 + h]; bff = p.in[2][j * 16 + (2 + dir) * 4 + h]; }
        else if (j != 0) {
#pragma unroll
            for (int e = 0; e < 2; ++e) { const float r0 = p.in[3][dir * 1024 + h * 128 + d + e], r1 = p.in[3][dir * 1024 + 512 + h * 128 + d + e]; oml[e] = rcpf_(1.0f + __expf(r1 - r0)); lb[e] = 1.0f - oml[e]; } }
        unsigned pqA[8], pgA[8], pqB[8], pgB[8]; bf16_t pgiA[8], pgfA[8], pgiB[8], pgfB[8]; u32x4 pv0A, pv1A, pv0B, pv1B;
        const unsigned lrow = (unsigned)(dir ? (24 - tq * 8) : tq * 8), lrowv = (unsigned)(dir ? (15 - vs_s) : vs_s);
        const unsigned lq = ML ? (lrow * DM + h * 128 + d) * 2u : (lrow * INP + C_AQ + h * 128 + d) * 2u;
        const unsigned lg = ML ? (lrow * DM + 512 + h * 128 + d) * 2u : (lrow * INP + zc + d) * 2u;
        const unsigned lgi = (lrow * INP + C_BG + dir * 4 + h) * 2u, lgf = (lrow * INP + C_BG + (2 + dir) * 4 + h) * 2u;
        const unsigned lv = (lrowv * INP + (ML ? C_BV : C_AI) + h * 128 + vs_c) * 2u;
        const char* gproj = (const char*)proj; const char* gmix = (const char*)mix;
#define SCAN_LOAD(c, S) do { \
        _Pragma("unroll") for (int i = 0; i < 8; ++i) { const size_t urow = rowbase + (size_t)(dir ? (SEQ - 32 - (c) * 32 + 7 - i) : ((c) * 32 + i)); \
            if (ML) { pq##S[i] = *(const unsigned*)(gmix + urow * (DM * 2) + lq); pg##S[i] = *(const unsigned*)(gmix + urow * (DM * 2) + lg); \
                      pgi##S[i] = *(const bf16_t*)(gproj + urow * (INP * 2) + lgi); pgf##S[i] = *(const bf16_t*)(gproj + urow * (INP * 2) + lgf); } \
            else { pq##S[i] = *(const unsigned*)(gproj + urow * (INP * 2) + lq); pg##S[i] = *(const unsigned*)(gproj + urow * (INP * 2) + lg); } } \
        { const size_t u0 = rowbase + (size_t)(dir ? (SEQ - 32 - (c) * 32 + 16) : ((c) * 32)), u1 = rowbase + (size_t)(dir ? (SEQ - 32 - (c) * 32) : ((c) * 32 + 16)); \
          pv0##S = *(const u32x4*)(gproj + u0 * (INP * 2) + lv); pv1##S = *(const u32x4*)(gproj + u1 * (INP * 2) + lv); } } while (0)
        float kk[2][8], qv[2][8], liv[8], cs[2][8], run[2];
#define SCAN_GATE_A(c, S) do { \
        LAS bf16_t* Vs = (LAS bf16_t*)(lds + ((c) & 1) * BUF) + 64 * RS + 32 * RT; \
        *(LAS u32x4*)(Vs + vs_s * RT + vs_c) = pv0##S; *(LAS u32x4*)(Vs + (vs_s + 16) * RT + vs_c) = pv1##S; \
        run[0] = 0.f; run[1] = 0.f; \
        _Pragma("unroll") for (int i = 0; i < 8; ++i) { \
            float lfs = 0.f; \
            if (ML) { liv[i] = bf1(pgi##S[i]) + bi; const float x = bf1(pgf##S[i]) + bff; lfs = fminf(x, 0.f) - logf_(1.0f + __expf(-fabsf(x))); } else liv[i] = 0.f; \
            _Pragma("unroll") for (int e = 0; e < 2; ++e) { \
                qv[e][i] = e ? bf_hi(pq##S[i]) : bf_lo(pq##S[i]); const float gval = e ? bf_hi(pg##S[i]) : bf_lo(pg##S[i]); float lf; \
                if (ML) { kk[e][i] = gval; lf = lfs; } \
                else { const float z = gval; const float ex = __expf(-fabsf(z)), r = rcpf_(1.0f + ex); const float sg = (z >= 0.f) ? r : ex * r, sgm = (z >= 0.f) ? ex * r : r; \
                    kk[e][i] = oml[e] * sgm; \
                    lf = logf_(lb[e] + oml[e] * sg); } \
                run[e] += lf; cs[e][i] = run[e]; } } } while (0)
#define SCAN_GATE_B(c) do { \
        LAS bf16_t* Qh = (LAS bf16_t*)(lds + ((c) & 1) * BUF); LAS bf16_t* Kh = Qh + 32 * RS; LAS bf16_t* Kt = Kh + 32 * RS; LAS float* dl = (LAS float*)(Kt + 64 * RT); \
        float prefix[2], blast[2], edl[2]; \
        _Pragma("unroll") for (int e = 0; e < 2; ++e) { const float x1 = __shfl_xor(run[e], 1), x2 = __shfl_xor(run[e], 2), x3 = __shfl_xor(run[e], 3); \
            prefix[e] = (tq == 0) ? 0.f : (tq == 1) ? x1 : (tq == 2) ? (x2 + x3) : (x1 + x2 + x3); blast[e] = (run[e] + x1) + (x2 + x3); edl[e] = __expf(blast[e]); } \
        _Pragma("unroll") for (int i = 0; i < 8; ++i) { const int t = tq * 8 + i; float qh[2], kh[2], kt[2]; \
            _Pragma("unroll") for (int e = 0; e < 2; ++e) { const float bt = prefix[e] + cs[e][i]; \
                qh[e] = qv[e][i] * __expf(bt); kh[e] = kk[e][i] * __expf(liv[i] - bt); kt[e] = kh[e] * edl[e]; } \
            *(LAS unsigned*)(Qh + t * RS + d) = pk2(qh[0], qh[1]); *(LAS unsigned*)(Kh + t * RS + d) = pk2(kh[0], kh[1]); *(LAS unsigned*)(Kt + t * RT + d) = pk2(kt[0], kt[1]); } \
        if (tq == 0) { dl[d] = edl[0]; dl[d + 1] = edl[1]; } } while (0)
#define SCAN_BAR() asm volatile("s_waitcnt lgkmcnt(0)\n\ts_barrier" ::: "memory")
        SCAN_LOAD(0, A);
        SCAN_LOAD(1, B);
        SCAN_GATE_A(0, A);
        SCAN_LOAD(2, A);
        SCAN_GATE_B(0);
        SCAN_BAR();
#pragma unroll 1
        for (int c = 0; c < NCH; c += 2) {
            if (c + 1 < NCH) { SCAN_GATE_A(c + 1, B); { const int cn = (c + 3 < NCH) ? (c + 3) : (NCH - 1); SCAN_LOAD(cn, B); } SCAN_GATE_B(c + 1); }
            SCAN_BAR();
            if (c + 2 < NCH) { SCAN_GATE_A(c + 2, A); { const int cn = (c + 4 < NCH) ? (c + 4) : (NCH - 1); SCAN_LOAD(cn, A); } SCAN_GATE_B(c + 2); }
            SCAN_BAR();
        }
#undef SCAN_LOAD
#undef SCAN_GATE_A
#undef SCAN_GATE_B
#undef SCAN_BAR
    } else {
        const int tid = tid_fresh(wv), wave = wv, lane = tid & 63, li = lane & 15, quad = lane >> 4;
        f32x4 Macc[2][8], nacc[8];
#pragma unroll
        for (int i = 0; i < 8; ++i) { Macc[0][i] = (f32x4){0.f, 0.f, 0.f, 0.f}; Macc[1][i] = (f32x4){0.f, 0.f, 0.f, 0.f}; nacc[i] = (f32x4){0.f, 0.f, 0.f, 0.f}; }
        union { bf16x8 v; unsigned u[4]; } ones; ones.u[0] = ones.u[1] = ones.u[2] = ones.u[3] = 0x3F803F80u;
        asm volatile("s_waitcnt lgkmcnt(0)\n\ts_barrier" ::: "memory");
#pragma unroll 1
        for (int c = 0; c < NCH; ++c) {
            const LAS bf16_t* Qh = (const LAS bf16_t*)(lds + (c & 1) * BUF); const LAS bf16_t* Kh = Qh + 32 * RS; const LAS bf16_t* Kt = Kh + 32 * RS; const LAS bf16_t* Vs = Kt + 32 * RT; const LAS float* dl = (const LAS float*)(Vs + 32 * RT);
            f32x4 at00 = {0.f, 0.f, 0.f, 0.f}, at01 = at00, at11 = at00;
#pragma unroll
            for (int ks = 0; ks < 4; ++ks) {
                const bf16x8 kf0 = *(const LAS bf16x8*)(Kh + li * RS + ks * 32 + quad * 8), kf1 = *(const LAS bf16x8*)(Kh + (16 + li) * RS + ks * 32 + quad * 8);
                const bf16x8 qf0 = *(const LAS bf16x8*)(Qh + li * RS + ks * 32 + quad * 8), qf1 = *(const LAS bf16x8*)(Qh + (16 + li) * RS + ks * 32 + quad * 8);
                at00 = __builtin_amdgcn_mfma_f32_16x16x32_bf16(kf0, qf0, at00, 0, 0, 0);
                at01 = __builtin_amdgcn_mfma_f32_16x16x32_bf16(kf0, qf1, at01, 0, 0, 0);
                at11 = __builtin_amdgcn_mfma_f32_16x16x32_bf16(kf1, qf1, at11, 0, 0, 0);
            }
#pragma unroll
            for (int jj = 0; jj < 4; ++jj) { const bool keep = (quad * 4 + jj) <= li; at00[jj] = keep ? at00[jj] : 0.f; at11[jj] = keep ? at11[jj] : 0.f; }
            union { bf16x8 v; unsigned u[4]; } pb0, pb1;
            pb0.u[0] = pk2(at00[0], at00[1]); pb0.u[1] = pk2(at00[2], at00[3]); pb0.u[2] = 0u; pb0.u[3] = 0u;
            pb1.u[0] = pk2(at01[0], at01[1]); pb1.u[1] = pk2(at01[2], at01[3]); pb1.u[2] = pk2(at11[0], at11[1]); pb1.u[3] = pk2(at11[2], at11[3]);
            bf16x8 av[2]; f32x4 ot[2][2], den0 = {0.f, 0.f, 0.f, 0.f}, den1 = den0;
#pragma unroll
            for (int ct = 0; ct < 2; ++ct) { const int col0 = 32 * wave + 16 * ct;
                const s16x4 va0 = __builtin_amdgcn_ds_read_tr16_b64_v4i16((LAS s16x4*)(Vs + (quad * 4 + (li >> 2)) * RT + col0 + (li & 3) * 4));
                const s16x4 va1 = __builtin_amdgcn_ds_read_tr16_b64_v4i16((LAS s16x4*)(Vs + (16 + quad * 4 + (li >> 2)) * RT + col0 + (li & 3) * 4));
                av[ct] = (bf16x8){va0[0], va0[1], va0[2], va0[3], va1[0], va1[1], va1[2], va1[3]};
                ot[ct][0] = __builtin_amdgcn_mfma_f32_16x16x32_bf16(av[ct], pb0.v, (f32x4){0.f, 0.f, 0.f, 0.f}, 0, 0, 0);
                ot[ct][1] = __builtin_amdgcn_mfma_f32_16x16x32_bf16(av[ct], pb1.v, (f32x4){0.f, 0.f, 0.f, 0.f}, 0, 0, 0); }
            if (ML) { den0 = __builtin_amdgcn_mfma_f32_16x16x32_bf16(ones.v, pb0.v, den0, 0, 0, 0); den1 = __builtin_amdgcn_mfma_f32_16x16x32_bf16(ones.v, pb1.v, den1, 0, 0, 0); }
#pragma unroll
            for (int k2 = 0; k2 < 4; ++k2) {
                union { bf16x8 v; unsigned u[4]; u32x2 h2[2]; } am, an, q0, q1;
                q0.h2[0] = *(const LAS u32x2*)(Qh + li * RS + (2 * k2) * 16 + quad * 4); q0.h2[1] = *(const LAS u32x2*)(Qh + li * RS + (2 * k2 + 1) * 16 + quad * 4);
                q1.h2[0] = *(const LAS u32x2*)(Qh + (16 + li) * RS + (2 * k2) * 16 + quad * 4); q1.h2[1] = *(const LAS u32x2*)(Qh + (16 + li) * RS + (2 * k2 + 1) * 16 + quad * 4);
#pragma unroll
                for (int ct = 0; ct < 2; ++ct) {
                    am.u[0] = pk2(Macc[ct][2 * k2][0], Macc[ct][2 * k2][1]); am.u[1] = pk2(Macc[ct][2 * k2][2], Macc[ct][2 * k2][3]); am.u[2] = pk2(Macc[ct][2 * k2 + 1][0], Macc[ct][2 * k2 + 1][1]); am.u[3] = pk2(Macc[ct][2 * k2 + 1][2], Macc[ct][2 * k2 + 1][3]);
                    ot[ct][0] = __builtin_amdgcn_mfma_f32_16x16x32_bf16(am.v, q0.v, ot[ct][0], 0, 0, 0);
                    ot[ct][1] = __builtin_amdgcn_mfma_f32_16x16x32_bf16(am.v, q1.v, ot[ct][1], 0, 0, 0); }
                if (ML) {
                    an.u[0] = pk2(nacc[2 * k2][0], nacc[2 * k2][1]); an.u[1] = pk2(nacc[2 * k2][2], nacc[2 * k2][3]); an.u[2] = pk2(nacc[2 * k2 + 1][0], nacc[2 * k2 + 1][1]); an.u[3] = pk2(nacc[2 * k2 + 1][2], nacc[2 * k2 + 1][3]);
                    den0 = __builtin_amdgcn_mfma_f32_16x16x32_bf16(an.v, q0.v, den0, 0, 0, 0);
                    den1 = __builtin_amdgcn_mfma_f32_16x16x32_bf16(an.v, q1.v, den1, 0, 0, 0);
                }
            }
#pragma unroll
            for (int tt = 0; tt < 2; ++tt) { float inv = 1.0f;
                if (ML) { const f32x4 dn = tt ? den1 : den0; inv = rcpf_(fmaxf(fabsf(dn[0]), 1.0f)); }
                const int g = c * 32 + tt * 16 + li; const size_t row = rowbase + (dir ? (SEQ - 1 - g) : g);
#pragma unroll
                for (int ct = 0; ct < 2; ++ct) { const f32x4 o = ot[ct][tt] * inv; u32x2 w; w.x = pk2(o[0], o[1]); w.y = pk2(o[2], o[3]);
                    *(u32x2*)(proj + row * INP + ocol + 32 * wave + 16 * ct + quad * 4) = w; } }
#pragma unroll
            for (int rt = 0; rt < 8; ++rt) {
                const s16x4 k0 = __builtin_amdgcn_ds_read_tr16_b64_v4i16((LAS s16x4*)(Kt + (quad * 4 + (li >> 2)) * RT + rt * 16 + (li & 3) * 4));
                const s16x4 k1 = __builtin_amdgcn_ds_read_tr16_b64_v4i16((LAS s16x4*)(Kt + (16 + quad * 4 + (li >> 2)) * RT + rt * 16 + (li & 3) * 4));
                const bf16x8 ka = {k0[0], k0[1], k0[2], k0[3], k1[0], k1[1], k1[2], k1[3]};
                const f32x4 dlv = *(const LAS f32x4*)(dl + rt * 16 + quad * 4);
                Macc[0][rt] = __builtin_amdgcn_mfma_f32_16x16x32_bf16(ka, av[0], Macc[0][rt] * dlv, 0, 0, 0);
                Macc[1][rt] = __builtin_amdgcn_mfma_f32_16x16x32_bf16(ka, av[1], Macc[1][rt] * dlv, 0, 0, 0);
                if (ML) nacc[rt] = __builtin_amdgcn_mfma_f32_16x16x32_bf16(ka, ones.v, nacc[rt] * dlv, 0, 0, 0);
            }
            asm volatile("s_waitcnt lgkmcnt(0)\n\ts_barrier" ::: "memory");
        }
    }
    __syncthreads();
}
__device__ __forceinline__ void scan_phase(const Params& p, int j, LAS unsigned char* lds, const int wv) {
    for (int chain = blockIdx.x; chain < 256; chain += gridDim.x) {
        const int type = chain >> 7, rem = chain & 127, dir = rem & 1, h = (rem >> 1) & 3, b = rem >> 3;
        if (type == 0) chunk_scan<false>(p, j, b, h, dir, lds, wv); else chunk_scan<true>(p, j, b, h, dir, lds, wv);
    }
}

__device__ __forceinline__ void combine_phase(const Params& p, int j, const int wv) {
    const bf16_t* proj = (const bf16_t*)(p.ws + WS_PROJ); bf16_t* mix = (bf16_t*)(p.ws + WS_MIX);
    const int tid = tid_fresh(wv), wave = tid >> 6, lane = tid & 63;
    const int isB = lane >> 5, cc = (lane & 31) * 16;
    const int c1 = isB ? C_BQ : C_AFF, c2 = isB ? C_BK : C_AFB, c3 = isB ? C_BO : C_AG;
    const float* gn = (isB ? p.in[6] : p.in[5]) + (size_t)j * 512 + cc;
    float gnv[16];
#pragma unroll
    for (int i = 0; i < 16; ++i) gnv[i] = gn[i];
    const int tstride = gridDim.x * 8;
    for (int tok0 = blockIdx.x * 8 + wave; tok0 < NTOK; tok0 += 2 * tstride) {
        u32x4 x1a[2], x1b[2], x2a[2], x2b[2], ga[2], gb[2];
#pragma unroll
        for (int q = 0; q < 2; ++q) { const int tok = min(tok0 + q * tstride, NTOK - 1); const bf16_t* rp = proj + (size_t)tok * INP;
            x1a[q] = *(const u32x4*)(rp + c1 + cc); x1b[q] = *(const u32x4*)(rp + c1 + cc + 8);
            x2a[q] = *(const u32x4*)(rp + c2 + cc); x2b[q] = *(const u32x4*)(rp + c2 + cc + 8);
            ga[q] = *(const u32x4*)(rp + c3 + cc); gb[q] = *(const u32x4*)(rp + c3 + cc + 8); }
#pragma unroll
        for (int q = 0; q < 2; ++q) { const int tok = tok0 + q * tstride;
            float s[16], g[16];
            const unsigned x1w[8] = {x1a[q].x, x1a[q].y, x1a[q].z, x1a[q].w, x1b[q].x, x1b[q].y, x1b[q].z, x1b[q].w};
            const unsigned x2w[8] = {x2a[q].x, x2a[q].y, x2a[q].z, x2a[q].w, x2b[q].x, x2b[q].y, x2b[q].z, x2b[q].w};
            const unsigned gw[8] = {ga[q].x, ga[q].y, ga[q].z, ga[q].w, gb[q].x, gb[q].y, gb[q].z, gb[q].w};
#pragma unroll
            for (int i = 0; i < 8; ++i) { s[2 * i] = bf_lo(x1w[i]) + bf_lo(x2w[i]); s[2 * i + 1] = bf_hi(x1w[i]) + bf_hi(x2w[i]); g[2 * i] = bf_lo(gw[i]); g[2 * i + 1] = bf_hi(gw[i]); }
            float sum = 0.f;
#pragma unroll
            for (int i = 0; i < 16; ++i) sum += s[i];
            sum += __shfl_xor(sum, 1); sum += __shfl_xor(sum, 2); sum += __shfl_xor(sum, 4);
            const float mu = isB ? sum * (1.f / 128.f) : 0.f;
            float sq = 0.f;
#pragma unroll
            for (int i = 0; i < 16; ++i) { s[i] -= mu; sq += s[i] * s[i]; }
            sq += __shfl_xor(sq, 1); sq += __shfl_xor(sq, 2); sq += __shfl_xor(sq, 4);
            const float rs = __builtin_amdgcn_rsqf(sq * (1.f / 128.f) + GN_EPS);
            float o[16];
#pragma unroll
            for (int i = 0; i < 16; ++i) { const float act = isB ? sigmoidf_(g[i]) : siluf_(g[i]); o[i] = s[i] * rs * gnv[i] * act; }
            u32x4 oa, ob; oa.x = pk2(o[0], o[1]); oa.y = pk2(o[2], o[3]); oa.z = pk2(o[4], o[5]); oa.w = pk2(o[6], o[7]);
            ob.x = pk2(o[8], o[9]); ob.y = pk2(o[10], o[11]); ob.z = pk2(o[12], o[13]); ob.w = pk2(o[14], o[15]);
            if (tok < NTOK) { bf16_t* op = mix + (size_t)tok * DM + isB * 512 + cc; *(u32x4*)op = oa; *(u32x4*)(op + 8) = ob; }
        }
    }
}

__device__ __forceinline__ void na_phase(const Params& p, int j, LAS unsigned char* lds, const int wv) {
    const char* gq = (const char*)(p.ws + WS_PROJ); char* gm = (char*)(p.ws + WS_MIX);
    const float* rpb = p.in[9] + (size_t)j * 32 * 15 * 31;
    const int wave = wv;
    LAS bf16_t* Vs = (LAS bf16_t*)(lds + wave * 16384);
    const int NGW = gridDim.x * 8;
    constexpr size_t TOKB = (size_t)QKVN * 2;
    for (int gw = blockIdx.x * 8 + wave; gw < 2048; gw += NGW) {
        int lane = (int)__builtin_amdgcn_mbcnt_hi(~0u, __builtin_amdgcn_mbcnt_lo(~0u, 0u)); asm volatile("" : "+v"(lane));
        const int li = lane & 15, quad = lane >> 4;
        const int combo = gw & 127, head = combo >> 2, n = combo & 3, b = gw >> 7;
        const int band0 = (n == 0) ? 0 : (n == 1) ? 8 : (n == 2) ? 24 : 32;
        const int qc = n * 16 + li, c0q = min(max(qc - 8, 0), 48);
        const unsigned klane = (unsigned)((li * QKVN + DM + head * 32 + quad * 8) * 2);
        const unsigned vlane = (unsigned)(((lane >> 2) * QKVN + 2 * DM + head * 32 + (lane & 3) * 8) * 2);
        const size_t qadj = (size_t)n * 16 * TOKB - (size_t)DM * 2;
        const unsigned olane = (unsigned)((qc * DM + head * 32 + quad * 4) * 2);
        int cur_dr = 99;
        unsigned biasp[16][2];
#pragma unroll
        for (int t = 0; t < 16; ++t) { biasp[t][0] = 0u; biasp[t][1] = 0u; }
        bf16x8 qf, kf[16];
        { const size_t bt0 = (size_t)b * SEQ + band0;
          qf = *(const bf16x8*)((uintptr_t)gq + ((size_t)b * SEQ * TOKB + qadj) + klane);
#pragma unroll
          for (int t = 0; t < 16; ++t) kf[t] = *(const bf16x8*)(gq + (bt0 + (t >> 1) * 64 + (t & 1) * 16) * TOKB + klane);
#pragma unroll
          for (int it = 0; it < 16; ++it)
              __builtin_amdgcn_global_load_lds((const unsigned*)(gq + (bt0 + (it >> 1) * 64 + (it & 1) * 16) * TOKB + vlane), (LAS unsigned*)(Vs + it * 512), 16, 0, 0); }
        int rot = 0;
#pragma unroll 1
        for (int r = 0; r < 64; ++r) {
            const int r0 = min(max(r - 4, 0), 56), dr = r0 - r;
            if (dr != cur_dr) {
#pragma unroll
                for (int t = 0; t < 16; ++t) { float bv[4];
#pragma unroll
                    for (int jj = 0; jj < 4; ++jj) { const int kc = band0 + (t & 1) * 16 + quad * 4 + jj; const bool valid = (kc >= c0q) && (kc < c0q + 16);
                        const int ri = dr + (t >> 1) + 7, ci = kc - qc + 15;
                        bv[jj] = valid ? rpb[(head * 15 + ri) * 31 + ci] : -1e30f; }
                    biasp[t][0] = pk2(bv[0], bv[1]); biasp[t][1] = pk2(bv[2], bv[3]);
                    if ((t & 3) == 3) __builtin_amdgcn_sched_barrier(0); }
                cur_dr = dr;
            }
            const size_t rowtok = (size_t)b * SEQ + (size_t)r * 64;
            const bool has_next = (r + 1 < 64);
            const bool slide = has_next && (min(max(r + 1 - 4, 0), 56) != r0);
            const size_t new_tok = (size_t)b * SEQ + (size_t)(r0 + 8) * 64 + band0;
            f32x4 st[16];
#pragma unroll
            for (int t = 0; t < 16; ++t) st[t] = __builtin_amdgcn_mfma_f32_16x16x32_bf16(kf[t], qf, (f32x4){0.f, 0.f, 0.f, 0.f}, 0, 0, 0);
            if (has_next) qf = *(const bf16x8*)((uintptr_t)gq + ((rowtok + 64) * TOKB + qadj) + klane);
            if (slide) {
#pragma unroll
                for (int t = 0; t < 14; ++t) kf[t] = kf[t + 2];
                kf[14] = *(const bf16x8*)(gq + new_tok * TOKB + klane);
                kf[15] = *(const bf16x8*)(gq + (new_tok + 16) * TOKB + klane);
            }
            float mx = -3e38f;
#pragma unroll
            for (int t = 0; t < 16; ++t)
#pragma unroll
                for (int jj = 0; jj < 4; ++jj) { const unsigned bw = biasp[t][jj >> 1]; const float bb = (jj & 1) ? bf_hi(bw) : bf_lo(bw); st[t][jj] = fmaf(st[t][jj], 0.17677669529663687f, bb); mx = fmaxf(mx, st[t][jj]); }
            mx = fmaxf(mx, __shfl_xor(mx, 16)); mx = fmaxf(mx, __shfl_xor(mx, 32));
            float l = 0.f;
#pragma unroll
            for (int t = 0; t < 16; ++t)
#pragma unroll
                for (int jj = 0; jj < 4; ++jj) { const float pj = __expf(st[t][jj] - mx); st[t][jj] = pj; l += pj; }
            l += __shfl_xor(l, 16); l += __shfl_xor(l, 32);
            if (slide) asm volatile("s_waitcnt vmcnt(3)" ::: "memory"); else if (has_next) asm volatile("s_waitcnt vmcnt(1)" ::: "memory"); else asm volatile("s_waitcnt vmcnt(0)" ::: "memory");
            f32x4 ot[2] = {(f32x4){0.f, 0.f, 0.f, 0.f}, (f32x4){0.f, 0.f, 0.f, 0.f}};
#pragma unroll
            for (int ks = 0; ks < 8; ++ks) {
                union { bf16x8 v; unsigned u[4]; } pb;
                pb.u[0] = pk2(st[2 * ks][0], st[2 * ks][1]); pb.u[1] = pk2(st[2 * ks][2], st[2 * ks][3]);
                pb.u[2] = pk2(st[2 * ks + 1][0], st[2 * ks + 1][1]); pb.u[3] = pk2(st[2 * ks + 1][2], st[2 * ks + 1][3]);
                const int slot = (ks + rot) & 7;
                const LAS bf16_t* vrow = Vs + (slot * 32 + quad * 4 + (li >> 2)) * 32 + (li & 3) * 4;
#pragma unroll
                for (int mt = 0; mt < 2; ++mt) {
                    const s16x4 a0 = __builtin_amdgcn_ds_read_tr16_b64_v4i16((LAS s16x4*)(vrow + mt * 16));
                    const s16x4 a1 = __builtin_amdgcn_ds_read_tr16_b64_v4i16((LAS s16x4*)(vrow + 16 * 32 + mt * 16));
                    const bf16x8 av = {a0[0], a0[1], a0[2], a0[3], a1[0], a1[1], a1[2], a1[3]};
                    ot[mt] = __builtin_amdgcn_mfma_f32_16x16x32_bf16(av, pb.v, ot[mt], 0, 0, 0);
                }
                if (ks & 1) __builtin_amdgcn_sched_barrier(0);
            }
            asm volatile("s_waitcnt lgkmcnt(0)" ::: "memory");
            const float inv = rcpf_(l);
#pragma unroll
            for (int mt = 0; mt < 2; ++mt) { u32x2 w; w.x = pk2(ot[mt][0] * inv, ot[mt][1] * inv); w.y = pk2(ot[mt][2] * inv, ot[mt][3] * inv);
                *(u32x2*)(gm + rowtok * (DM * 2) + olane + mt * 32) = w; }
            if (slide) {
#pragma unroll
                for (int hf = 0; hf < 2; ++hf)
                    __builtin_amdgcn_global_load_lds((const unsigned*)(gq + (new_tok + hf * 16) * TOKB + vlane), (LAS unsigned*)(Vs + (rot * 2 + hf) * 512), 16, 0, 0);
                rot = (rot + 1) & 7;
            }
        }
        asm volatile("s_waitcnt vmcnt(0)" ::: "memory");
    }
}

#define XB_TMO      128
#define XB_XCNT(j)  (256  + 64 * (j))
#define XB_XSUB(j)  (1280 + 64 * (j))
#define XB_XGEN(j)  (2304 + 64 * (j))
#define XB_TOP      3328
#define XB_TOPGEN   3392
#define XCD_BAR_WORDS 3456
#define XB_SPIN_CAP (1u << 18)
__device__ __forceinline__ unsigned xb_ld(unsigned* p)              { return __hip_atomic_load(p, __ATOMIC_RELAXED, __HIP_MEMORY_SCOPE_AGENT); }
__device__ __forceinline__ unsigned xb_add(unsigned* p, unsigned v) { return __hip_atomic_fetch_add(p, v, __ATOMIC_RELAXED, __HIP_MEMORY_SCOPE_AGENT); }
__device__ __forceinline__ unsigned xb_xcc_id() { return (unsigned)__builtin_amdgcn_s_getreg((3 << 11) | 20) & 0xFu; }
#define XB_SPIN(cond, bar) do { unsigned _sp = 0; while (cond) { __builtin_amdgcn_s_sleep(1); \
    if ((++_sp & 255u) == 0u) { if (xb_ld(&(bar)[XB_TMO])) break; if (_sp > XB_SPIN_CAP) { atomicAdd(&(bar)[XB_TMO], 1u); break; } } } } while (0)
struct XcdBarrier { unsigned* bar; unsigned x; volatile LAS unsigned* st; int wv; };
__device__ __forceinline__ XcdBarrier xcd_barrier_post(unsigned* bar, volatile LAS unsigned* st, const int wv) {
    XcdBarrier b; b.bar = bar; b.x = xb_xcc_id(); b.st = st; b.wv = wv;
    if (wv == 0 && lane_id() == 0) (void)xb_add(&bar[XB_XCNT(b.x)], 1u);
    return b;
}
__device__ __forceinline__ void xcd_barrier_complete(unsigned* bar, unsigned x, unsigned& nloc, unsigned& nx) {
    const unsigned G = gridDim.x * gridDim.y * gridDim.z;
    unsigned sum, cnt, mine, sp = 0u;
    for (;;) {
        sum = 0u; cnt = 0u; mine = 0u;
#pragma unroll
        for (unsigned j = 0; j < 16; ++j) { const unsigned c = xb_ld(&bar[XB_XCNT(j)]); sum += c; cnt += (c > 0u) ? 1u : 0u; mine = (j == x) ? c : mine; }
        if (sum == G) break;
        __builtin_amdgcn_s_sleep(1);
        if ((++sp & 255u) == 0u) { if (xb_ld(&bar[XB_TMO])) break; if (sp > XB_SPIN_CAP) { atomicAdd(&bar[XB_TMO], 1u); break; } }
    }
    nloc = mine > 0u ? mine : 1u; nx = cnt > 0u ? cnt : 1u;
}
__device__ __forceinline__ void xcd_barrier(const XcdBarrier& b) {
    asm volatile("s_waitcnt vmcnt(0)" ::: "memory");
    __syncthreads();
    if (b.wv == 0 && lane_id() == 0) {
        unsigned* bar = b.bar;
        __builtin_amdgcn_s_waitcnt(0);
        unsigned nloc = b.st[0], nx = b.st[1];
        if (nloc == 0u) { xcd_barrier_complete(bar, b.x, nloc, nx); b.st[0] = nloc; b.st[1] = nx; }
        const unsigned old = xb_add(&bar[XB_XSUB(b.x)], 1u);
        const unsigned gen = old / nloc;
        if (old + 1u == (gen + 1u) * nloc) {
            __builtin_amdgcn_fence(__ATOMIC_RELEASE, "agent");
            asm volatile("s_waitcnt vmcnt(0)" ::: "memory");
            const unsigned og = xb_add(&bar[XB_TOP], 1u);
            const unsigned tg = og / nx;
            if (og + 1u == (tg + 1u) * nx) xb_add(&bar[XB_TOPGEN], 1u);
            else XB_SPIN(xb_ld(&bar[XB_TOPGEN]) == tg, bar);
            __builtin_amdgcn_fence(__ATOMIC_ACQUIRE, "agent");
            xb_add(&bar[XB_XGEN(b.x)], 1u);
            asm volatile("s_waitcnt vmcnt(0)" ::: "memory");
        } else {
            XB_SPIN(xb_ld(&bar[XB_XGEN(b.x)]) == gen, bar);
            __builtin_amdgcn_fence(__ATOMIC_ACQUIRE, "agent");
            asm volatile("s_waitcnt vmcnt(0)" ::: "memory");
        }
    }
    __syncthreads();
}

__global__ void __launch_bounds__(512, 2) mega_fwd(Params p) {
    extern __shared__ __attribute__((aligned(16))) unsigned char shm[];
    LAS unsigned char* lds = (LAS unsigned char*)shm;
    cg::grid_group grid = cg::this_grid();
    bf16_t* WT = (bf16_t*)(p.ws + WS_WT); bf16_t* HB = (bf16_t*)(p.ws + WS_HB); bf16_t* PROJ = (bf16_t*)(p.ws + WS_PROJ); bf16_t* MIX = (bf16_t*)(p.ws + WS_MIX);
    unsigned short* R16 = (unsigned short*)((char*)p.out + (size_t)NTOK * DM * 2);
    const int wv = __builtin_amdgcn_readfirstlane((int)(threadIdx.x >> 6));
    volatile LAS unsigned* xbst = (volatile LAS unsigned*)(lds + 131072);
    if (wv == 0 && lane_id() == 0) { xbst[0] = 0u; xbst[1] = 0u; xbst[2] = 0u; xbst[3] = 0u; }
    __syncthreads();
    const XcdBarrier xb = xcd_barrier_post((unsigned*)(p.ws + WS_BAR), xbst, wv);
    p0_phase(p, lds, wv);
    grid.sync();
    for (int l = 0; l < 4; ++l) {
        const int j = l >> 1; const bool even = (l & 1) == 0; const bf16_t* wl = WT + (size_t)l * LAYER_W_ELEMS;
        {
            const int N = even ? INP : QKVN;
            pg8::StaticOrder S; S.init(NTOK, N, (int)gridDim.x, (int)blockIdx.x);
            pg8::EpiStoreBf16 E; E.O = PROJ; E.ldc = N;
            pg8::Gemm g; g.A = HB; g.Bt = wl; g.M = NTOK; g.N = N; g.K = DM;
            pg8::gemm_phase(lds, g, S, E, wv);
        }
        xcd_barrier(xb);
        if (even) {
            conv_phase(p, j, wv);
            xcd_barrier(xb);
            scan_phase(p, j, lds, wv);
            xcd_barrier(xb);
            combine_phase(p, j, wv);
        } else {
            na_phase(p, j, lds, wv);
        }
        xcd_barrier(xb);
        gemm_ln_phase(lds, MIX, wl + OFF_WOUT, DM, (unsigned short*)p.out, p.out, HB, R16, p.in[11] + l * DM, p.in[12] + l * DM, false, wv);
        xcd_barrier(xb);
        {
            pg8::StaticOrder S; S.init(NTOK, GUN, (int)gridDim.x, (int)blockIdx.x);
            pg8::EpiSwiglu E; E.O = PROJ; E.ldc = FF;
            pg8::Gemm g; g.A = HB; g.Bt = wl + OFF_WGU; g.M = NTOK; g.N = GUN; g.K = DM;
            pg8::gemm_phase(lds, g, S, E, wv);
        }
        xcd_barrier(xb);
        gemm_ln_phase(lds, PROJ, wl + OFF_WD, FF, (unsigned short*)MIX, p.out, HB, R16, p.in[13] + l * DM, p.in[14] + l * DM, l == 3, wv);
        xcd_barrier(xb);
    }
}

extern "C" void kernel_launch(void* const* d_in, const int* in_sizes, int n_in, void* d_out, int out_size, void* d_ws, size_t ws_size, hipStream_t stream) {
    static int grid_blocks = 0;
    if (grid_blocks == 0) {
        if (n_in != 18 || out_size != NTOK * DM || ws_size < WS_TOTAL) { fprintf(stderr, "kernel_launch: unexpected problem (n_in %d out %d ws %zu need %zu)\n", n_in, out_size, ws_size, (size_t)WS_TOTAL); grid_blocks = -1; return; }
        int dev = 0, cus = 0, per_cu = 0;
        hipGetDevice(&dev);
        hipDeviceGetAttribute(&cus, hipDeviceAttributeMultiprocessorCount, dev);
        if (hipFuncSetAttribute((const void*)mega_fwd, hipFuncAttributeMaxDynamicSharedMemorySize, LDS_BYTES) != hipSuccess) { fprintf(stderr, "kernel_launch: hipFuncSetAttribute failed\n"); }
        if (hipOccupancyMaxActiveBlocksPerMultiprocessor(&per_cu, (const void*)mega_fwd, 512, LDS_BYTES) != hipSuccess || per_cu < 1) { fprintf(stderr, "kernel_launch: occupancy query gives %d\n", per_cu); per_cu = 1; }
        (void)hipGetLastError();
        grid_blocks = cus * per_cu;
    }
    if (grid_blocks < 0) return;
    if (hipMemsetAsync((char*)d_ws + WS_BAR, 0, XCD_BAR_WORDS * 4, stream) != hipSuccess) { fprintf(stderr, "kernel_launch: memset of barrier words failed\n"); return; }
    Params p{};
    for (int i = 0; i < 18; ++i) p.in[i] = (const float*)d_in[i];
    p.out = (float*)d_out; p.ws = (unsigned char*)d_ws;
    void* args[] = {&p};
    hipError_t e = hipLaunchCooperativeKernel((const void*)mega_fwd, dim3(grid_blocks), dim3(512), args, LDS_BYTES, stream);
    if (e != hipSuccess) fprintf(stderr, "cooperative launch failed: %s (grid %d)\n", hipGetErrorString(e), grid_blocks);
}
```

```cpp
#include <hip/hip_runtime.h>
#include <hip/hip_cooperative_groups.h>
#include <cstdio>
#include <cstdint>
namespace cg = cooperative_groups;

#define LAS __attribute__((address_space(3)))
typedef unsigned short bf16_t;
typedef short bf16x8 __attribute__((ext_vector_type(8)));
typedef float f32x4 __attribute__((ext_vector_type(4)));
typedef unsigned u32x4 __attribute__((ext_vector_type(4)));
typedef unsigned u32x2 __attribute__((ext_vector_type(2)));
typedef short s16x4 __attribute__((ext_vector_type(4)));

constexpr int SEQ = 4096, DM = 1024, NTOK = 65536, NPANEL = 256;
constexpr int INC = 4624, INP = 4864, QKVN = 3072, FF = 2816, GUN = 5632;
constexpr int C_AQ = 0, C_AFF = 512, C_AFB = 1024, C_AI = 1536, C_AG = 2048, C_BQ = 2560, C_BK = 3072, C_BV = 3584, C_BO = 4096, C_BG = 4608;
constexpr float ALPHA = 1.681792830507429f;
constexpr float LN_EPS = 1e-5f, GN_EPS = 1e-6f;
constexpr size_t W_IN_ELEMS = (size_t)INP * DM, W_OUT_ELEMS = (size_t)DM * DM, W_GU_ELEMS = (size_t)GUN * DM, W_D_ELEMS = (size_t)DM * FF;
constexpr size_t OFF_WOUT = W_IN_ELEMS, OFF_WGU = OFF_WOUT + W_OUT_ELEMS, OFF_WD = OFF_WGU + W_GU_ELEMS, LAYER_W_ELEMS = OFF_WD + W_D_ELEMS;
constexpr size_t WS_WT = 0, WS_HB = WS_WT + 4 * LAYER_W_ELEMS * 2, WS_PROJ = WS_HB + (size_t)NTOK * DM * 2, WS_MIX = WS_PROJ + (size_t)NTOK * INP * 2, WS_END = WS_MIX + (size_t)NTOK * DM * 2;
constexpr size_t WS_BAR = WS_END, WS_TOTAL = WS_BAR + 16384;
constexpr int LDS_BYTES = 131072 + 16;

struct Params {
    const float* in[18];
    float* out;
    unsigned char* ws;
};

typedef float f32x2 __attribute__((ext_vector_type(2)));
typedef __bf16 bf16x2v __attribute__((ext_vector_type(2)));
__device__ __forceinline__ unsigned pk2(float lo, float hi) { const f32x2 f = {lo, hi}; const bf16x2v b = __builtin_convertvector(f, bf16x2v); return __builtin_bit_cast(unsigned, b); }
__device__ __forceinline__ float bf_lo(unsigned u) { return __uint_as_float(u << 16); }
__device__ __forceinline__ float bf_hi(unsigned u) { return __uint_as_float(u & 0xffff0000u); }
typedef _Float16 f16x2v __attribute__((ext_vector_type(2)));
__device__ __forceinline__ unsigned pkh2(float lo, float hi) { const f32x2 f = {lo, hi}; const f16x2v h = __builtin_convertvector(f, f16x2v); return __builtin_bit_cast(unsigned, h); }
__device__ __forceinline__ float h_lo(unsigned u) { const f16x2v h = __builtin_bit_cast(f16x2v, u); return (float)h[0]; }
__device__ __forceinline__ float h_hi(unsigned u) { const f16x2v h = __builtin_bit_cast(f16x2v, u); return (float)h[1]; }
__device__ __forceinline__ float bf1(bf16_t b) { return __uint_as_float(((unsigned)b) << 16); }
__device__ __forceinline__ float logf_(float x) { return __builtin_amdgcn_logf(x) * 0.6931471805599453f; }
__device__ __forceinline__ float rcpf_(float x) { return __builtin_amdgcn_rcpf(x); }
__device__ __forceinline__ float sigmoidf_(float x) { return rcpf_(1.0f + __expf(-x)); }
__device__ __forceinline__ float siluf_(float x) { return x * rcpf_(1.0f + __expf(-x)); }
__device__ __forceinline__ int lane_id() { int l; asm volatile("v_mbcnt_lo_u32_b32 %0, -1, 0\n\tv_mbcnt_hi_u32_b32 %0, -1, %0" : "=v"(l)); return l; }
__device__ __forceinline__ int tid_fresh(int wv) { int t = wv * 64 + lane_id(); asm volatile("" : "+v"(t)); return t; }
__device__ __forceinline__ float wave_sum(float v) {
#pragma unroll
    for (int o = 1; o < 64; o <<= 1) v += __shfl_xor(v, o);
    return v;
}

namespace pg8 {
constexpr int BM = 256, BK = 64, HALF = 128, HTB = HALF * BK * 2, NXCD = 8, WGM = 8;
__device__ __forceinline__ int lds_byte(int r, int c) { const int st = (r >> 4) * 2 + (c >> 5), rr = r & 15, cc = c & 31, ob = rr * 64 + cc * 2; return st * 1024 + (ob ^ (((ob >> 9) & 1) << 5)); }
__device__ __forceinline__ void stage_rc(int b, int& R, int& C) { const int st = b / 1024, sb = b % 1024, swz = sb ^ (((sb >> 9) & 1) << 5); R = (st >> 1) * 16 + swz / 64; C = (st & 1) * 32 + (swz % 64) / 2; }
__device__ __forceinline__ int perm32(int rho) { const int n = rho >> 4, i = rho & 15; return 8 * (i >> 2) + 4 * n + (i & 3); }
struct Unit { int pm, pn; };
struct Gemm { const bf16_t* A; const bf16_t* Bt; int M, N, K; };
struct StaticOrder {
    int nM, nN, nwg, G, c;
    __device__ void init(int M, int N, int G_, int c_) { nM = M / BM; nN = N / BM; nwg = nM * nN; G = G_; c = c_; }
    __device__ bool next(int i, Unit& u) const {
        const long L = (long)i * G + c; if (L >= nwg) return false;
        int wgid = (int)L; { const int q = nwg / NXCD, r = nwg % NXCD, xcd = wgid % NXCD, off = wgid / NXCD; wgid = (xcd < r ? xcd * (q + 1) : r * (q + 1) + (xcd - r) * q) + off; }
        const int nig = WGM * nN, gid = wgid / nig, fm = gid * WGM, gsz = (nM - fm) < WGM ? (nM - fm) : WGM;
        u.pm = fm + ((wgid % nig) % gsz); u.pn = (wgid % nig) / gsz; return true;
    }
};
struct PanelOrder {
    int pm, nN;
    __device__ bool next(int i, Unit& u) const { if (i >= nN) return false; u.pm = pm; u.pn = i; return true; }
};
struct EpiStoreBf16 {
    static constexpr bool PERM = true, ALIGN = true;
    bf16_t* O; int ldc;
    __device__ __forceinline__ void operator()(const f32x4 (&acc)[2][2][4][2], const Unit& u, int wr, int wc, int fr, int fq) const {
        const int row0 = u.pm * BM + wr * 64 + fr, col0 = u.pn * BM + wc * 32 + 8 * fq;
#pragma unroll
        for (int ai = 0; ai < 2; ++ai)
#pragma unroll
            for (int m = 0; m < 4; ++m) { bf16_t* rowp = O + (size_t)(row0 + ai * HALF + m * 16) * ldc + col0;
#pragma unroll
                for (int bj = 0; bj < 2; ++bj) { const f32x4 v0 = acc[ai][bj][m][0], v1 = acc[ai][bj][m][1];
                    u32x4 w; w.x = pk2(v0[0], v0[1]); w.y = pk2(v0[2], v0[3]); w.z = pk2(v1[0], v1[1]); w.w = pk2(v1[2], v1[3]);
                    *(u32x4*)(rowp + bj * HALF) = w; }
                asm volatile("" ::: "memory"); }
    }
};
struct EpiSwiglu {
    static constexpr bool PERM = true, ALIGN = true;
    bf16_t* O; int ldc;
    __device__ __forceinline__ void operator()(const f32x4 (&acc)[2][2][4][2], const Unit& u, int wr, int wc, int fr, int fq) const {
        const int row0 = u.pm * BM + wr * 64 + fr, col0 = u.pn * HALF + wc * 32 + 8 * fq;
#pragma unroll
        for (int ai = 0; ai < 2; ++ai)
#pragma unroll
            for (int m = 0; m < 4; ++m) { bf16_t* rowp = O + (size_t)(row0 + ai * HALF + m * 16) * ldc + col0;
                float hv[8];
#pragma unroll
                for (int n = 0; n < 2; ++n)
#pragma unroll
                    for (int jj = 0; jj < 4; ++jj) { const float g = acc[ai][0][m][n][jj], uu = acc[ai][1][m][n][jj]; hv[n * 4 + jj] = siluf_(g) * uu; }
                u32x4 w; w.x = pk2(hv[0], hv[1]); w.y = pk2(hv[2], hv[3]); w.z = pk2(hv[4], hv[5]); w.w = pk2(hv[6], hv[7]);
                *(u32x4*)rowp = w;
                asm volatile("" ::: "memory"); }
    }
};
struct EpiResid {
    static constexpr bool PERM = false, ALIGN = false;
    unsigned short* Y; const unsigned short* R; float alpha; bool res_bf16;
    __device__ __forceinline__ void operator()(const f32x4 (&acc)[2][2][4][2], const Unit& u, int wr, int wc, int fr, int fq) const {
        const int row0 = u.pm * BM + wr * 64 + fr, col0 = u.pn * BM + wc * 32 + 4 * fq;
        const size_t off0 = (size_t)row0 * DM + col0;
        u32x2 hv[2][4][2][2];
#pragma unroll
        for (int ai = 0; ai < 2; ++ai)
#pragma unroll
            for (int m = 0; m < 4; ++m)
#pragma unroll
                for (int bj = 0; bj < 2; ++bj)
#pragma unroll
                    for (int n = 0; n < 2; ++n) hv[ai][m][bj][n] = *(const u32x2*)(R + off0 + (size_t)(ai * HALF + m * 16) * DM + bj * HALF + n * 16);
#pragma unroll
        for (int ai = 0; ai < 2; ++ai)
#pragma unroll
            for (int m = 0; m < 4; ++m)
#pragma unroll
                for (int bj = 0; bj < 2; ++bj)
#pragma unroll
                    for (int n = 0; n < 2; ++n) { const u32x2 w = hv[ai][m][bj][n];
                        const f32x4 r = res_bf16 ? (f32x4){bf_lo(w.x), bf_hi(w.x), bf_lo(w.y), bf_hi(w.y)} : (f32x4){h_lo(w.x), h_hi(w.x), h_lo(w.y), h_hi(w.y)};
                        const f32x4 y = r * alpha + acc[ai][bj][m][n]; u32x2 o; o.x = pkh2(y[0], y[1]); o.y = pkh2(y[2], y[3]);
                        *(u32x2*)(Y + off0 + (size_t)(ai * HALF + m * 16) * DM + bj * HALF + n * 16) = o; }
    }
};

template <class Epi, class Sched>
__device__ __forceinline__ void gemm_phase(LAS unsigned char* lds, const Gemm g, const Sched& S, const Epi& E, const int wv) {
    const int tid = tid_fresh(wv), wid = __builtin_amdgcn_readfirstlane(tid >> 6), lane = tid & 63, wr = wid >> 2, wc = wid & 3, fr = lane & 15, fq = lane >> 4;
    const int K = g.K, nt = K / BK;
    unsigned voffA[2], voffB[2];
#pragma unroll
    for (int i = 0; i < 2; ++i) { int R, C; stage_rc(tid * 16 + i * 8192, R, C); const int Rb = Epi::PERM ? ((R & ~31) + perm32(R & 31)) : R;
        voffA[i] = (unsigned)(R * K + C) * 2u; voffB[i] = (unsigned)(Rb * K + C) * 2u; }
    const size_t kstep = (size_t)(BK * 2);
    const size_t hstep = (size_t)HALF * K * 2;
    const size_t tstep = 2 * hstep;
    const unsigned ldsw = (unsigned)wid * 1024u;
    const int aoff = lds_byte(wr * 64 + fr, fq * 8), boff = lds_byte(wc * 32 + fr, fq * 8);
#define PG8_SA(b, h) (((b) * 2 + (h)) * HTB)
#define PG8_SB(b, h) ((4 + (b) * 2 + (h)) * HTB)
#define PG8_STAGE(bufoff, gbase, voff) do { _Pragma("unroll") for (int _i = 0; _i < 2; ++_i) \
        __builtin_amdgcn_global_load_lds((const unsigned*)((const char*)(gbase) + (voff)[_i]), (LAS unsigned*)(lds + (bufoff) + ldsw + _i * 8192), 16, 0, 0); } while (0)
#define PG8_LDA(dst, b, h) do { _Pragma("unroll") for (int m = 0; m < 4; ++m) _Pragma("unroll") for (int k = 0; k < 2; ++k) dst[m][k] = *(const LAS bf16x8*)(lds + PG8_SA(b, h) + aoff + m * 2048 + k * 1024); } while (0)
#define PG8_LDB(dst, b, h) do { _Pragma("unroll") for (int n = 0; n < 2; ++n) _Pragma("unroll") for (int k = 0; k < 2; ++k) dst[n][k] = *(const LAS bf16x8*)(lds + PG8_SB(b, h) + boff + n * 2048 + k * 1024); } while (0)
#define PG8_MMA(ai, bj, At, Bt) do { __builtin_amdgcn_s_setprio(1); _Pragma("unroll") for (int m = 0; m < 4; ++m) _Pragma("unroll") for (int n = 0; n < 2; ++n) _Pragma("unroll") for (int k = 0; k < 2; ++k) \
        acc[ai][bj][m][n] = __builtin_amdgcn_mfma_f32_16x16x32_bf16(Bt[n][k], At[m][k], acc[ai][bj][m][n], 0, 0, 0); __builtin_amdgcn_s_setprio(0); } while (0)
#define PG8_WAIT_V(n) asm volatile("s_waitcnt vmcnt(" #n ")" ::: "memory")
#define PG8_WAIT_L(n) asm volatile("s_waitcnt lgkmcnt(" #n ")" ::: "memory")
#define PG8_BAR __builtin_amdgcn_s_barrier()
#define PG8_SCHED __builtin_amdgcn_sched_barrier(0)
    Unit cur, nxt; int ui = 0;
    if (!S.next(0, cur)) return;
    f32x4 acc[2][2][4][2];
#pragma unroll
    for (int a = 0; a < 2; ++a)
#pragma unroll
        for (int b = 0; b < 2; ++b)
#pragma unroll
            for (int m = 0; m < 4; ++m)
#pragma unroll
                for (int n = 0; n < 2; ++n) acc[a][b][m][n] = (f32x4){0.f, 0.f, 0.f, 0.f};
    bf16x8 At[4][2], B0[2][2], B1[2][2];
    const char* cA = (const char*)g.A + (size_t)cur.pm * tstep; const char* cB = (const char*)g.Bt + (size_t)cur.pn * tstep;
    PG8_STAGE(PG8_SB(0, 0), cB, voffB); PG8_STAGE(PG8_SB(0, 1), cB + hstep, voffB); PG8_STAGE(PG8_SA(0, 0), cA, voffA); PG8_STAGE(PG8_SA(0, 1), cA + hstep, voffA);
    if (wr == 1) PG8_BAR;
    PG8_WAIT_V(2); PG8_BAR;
    PG8_STAGE(PG8_SB(1, 0), cB + kstep, voffB); PG8_STAGE(PG8_SA(1, 0), cA + kstep, voffA); PG8_STAGE(PG8_SB(1, 1), cB + hstep + kstep, voffB);
    PG8_WAIT_V(6); PG8_BAR;
    for (;;) {
        const bool has_next = S.next(ui + 1, nxt);
        const char* nA = has_next ? (const char*)g.A + (size_t)nxt.pm * tstep : cA; const char* nB = has_next ? (const char*)g.Bt + (size_t)nxt.pn * tstep : cB;
        for (int t = 0; t < nt; t += 2) {
            const bool last = (t == nt - 2);
            const char* a1 = cA + (size_t)(t + 1) * kstep;
            const char* a2 = last ? nA : cA + (size_t)(t + 2) * kstep; const char* b2 = last ? nB : cB + (size_t)(t + 2) * kstep;
            const char* a3 = a2 + kstep; const char* b3 = b2 + kstep;
            PG8_LDB(B0, 0, 0); PG8_LDB(B1, 0, 1); PG8_SCHED; PG8_LDA(At, 0, 0); PG8_STAGE(PG8_SA(1, 1), a1 + hstep, voffA);
            PG8_WAIT_V(8); PG8_WAIT_L(0); PG8_BAR; PG8_MMA(0, 0, At, B0); PG8_MMA(0, 1, At, B1); PG8_BAR; PG8_SCHED;
            PG8_LDA(At, 0, 1); PG8_STAGE(PG8_SB(0, 0), b2, voffB); PG8_STAGE(PG8_SB(0, 1), b2 + hstep, voffB); PG8_STAGE(PG8_SA(0, 0), a2, voffA);
            PG8_WAIT_V(8); PG8_WAIT_L(0); PG8_BAR; PG8_MMA(1, 0, At, B0); PG8_MMA(1, 1, At, B1); PG8_BAR; PG8_SCHED;
            PG8_LDB(B0, 1, 0); PG8_LDB(B1, 1, 1); PG8_SCHED; PG8_LDA(At, 1, 0); PG8_STAGE(PG8_SA(0, 1), a2 + hstep, voffA);
            PG8_WAIT_V(8); PG8_WAIT_L(0); PG8_BAR; PG8_MMA(0, 0, At, B0); PG8_MMA(0, 1, At, B1); PG8_BAR; PG8_SCHED;
            PG8_LDA(At, 1, 1); PG8_STAGE(PG8_SB(1, 0), b3, voffB); PG8_STAGE(PG8_SB(1, 1), b3 + hstep, voffB); PG8_STAGE(PG8_SA(1, 0), a3, voffA);
            PG8_WAIT_V(8); PG8_WAIT_L(0); PG8_BAR; PG8_MMA(1, 0, At, B0); PG8_MMA(1, 1, At, B1); PG8_BAR; PG8_SCHED;
        }
        if (Epi::ALIGN) { if (wr == 0) PG8_BAR; }
        E(acc, cur, wr, wc, fr, fq);
        if (!has_next) break;
#pragma unroll
        for (int a = 0; a < 2; ++a)
#pragma unroll
            for (int b = 0; b < 2; ++b)
#pragma unroll
                for (int m = 0; m < 4; ++m)
#pragma unroll
                    for (int n = 0; n < 2; ++n) acc[a][b][m][n] = (f32x4){0.f, 0.f, 0.f, 0.f};
        cur = nxt; cA = nA; cB = nB; ++ui;
        if (Epi::ALIGN) { if (wr == 1) PG8_BAR; }
    }
    PG8_WAIT_V(0);
    if (!Epi::ALIGN) { if (wr == 0) PG8_BAR; }
    PG8_BAR;
#undef PG8_SA
#undef PG8_SB
#undef PG8_STAGE
#undef PG8_LDA
#undef PG8_LDB
#undef PG8_MMA
#undef PG8_WAIT_V
#undef PG8_WAIT_L
#undef PG8_BAR
#undef PG8_SCHED
}
}

__device__ __forceinline__ void tr_item(const float* W, int ldw, int colbase, int nvalid, bf16_t* dst, int K, int n0, int k0, LAS float* scr, int lane) {
#pragma unroll 16
    for (int i = 0; i < 32; ++i) { const int kk = 2 * i + (lane >> 5), c = lane & 31;
        scr[kk * 33 + c] = (c < nvalid) ? W[(size_t)(k0 + kk) * ldw + colbase + c] : 0.0f; }
    asm volatile("s_waitcnt lgkmcnt(0)" ::: "memory");
    const int c = lane & 7;
#pragma unroll
    for (int j = 0; j < 4; ++j) { const int n = (lane >> 3) + 8 * j; const LAS float* s = scr + (8 * c) * 33 + n;
        u32x4 o; o.x = pk2(s[0 * 33], s[1 * 33]); o.y = pk2(s[2 * 33], s[3 * 33]); o.z = pk2(s[4 * 33], s[5 * 33]); o.w = pk2(s[6 * 33], s[7 * 33]);
        *(u32x4*)(dst + (size_t)(n0 + n) * K + k0 + 8 * c) = o; }
    asm volatile("s_waitcnt lgkmcnt(0)" ::: "memory");
}
__device__ __forceinline__ void tr_plain(const float* W, int ldw, int nsrc, int K, bf16_t* dst, int ndst, LAS float* scr, int lane, int gw, int NGW, int& base) {
    const int nblk = ndst / 32, nitems = nblk * (K / 64);
    const int first = ((gw - (base % NGW)) % NGW + NGW) % NGW;
    for (int it = first; it < nitems; it += NGW) { const int kb = it / nblk, nb = it % nblk, n0 = nb * 32;
        tr_item(W, ldw, n0, nsrc - n0, dst, K, n0, kb * 64, scr, lane); }
    base += nitems;
}
__device__ __forceinline__ void tr_gu(const float* Wg, const float* Wu, bf16_t* dst, LAS float* scr, int lane, int gw, int NGW, int& base) {
    const int nblk = GUN / 32, nitems = nblk * (DM / 64);
    const int first = ((gw - (base % NGW)) % NGW + NGW) % NGW;
    for (int it = first; it < nitems; it += NGW) { const int kb = it / nblk, nb = it % nblk, n0 = nb * 32;
        const int q = n0 >> 7, tile = q >> 1, isup = q & 1;
        tr_item(isup ? Wu : Wg, FF, tile * 128 + (n0 & 127), 32, dst, DM, n0, kb * 64, scr, lane); }
    base += nitems;
}
__device__ __forceinline__ void p0_phase(const Params& p, LAS unsigned char* lds, const int wv) {
    const int tid = tid_fresh(wv), wave = tid >> 6, lane = tid & 63;
    const int gw = blockIdx.x * 8 + wave, NGW = gridDim.x * 8;
    LAS float* scr = (LAS float*)(lds + wave * 16384);
    bf16_t* WT = (bf16_t*)(p.ws + WS_WT);
    int base = 0;
    for (int l = 0; l < 4; ++l) { const int j = l >> 1; bf16_t* wl = WT + (size_t)l * LAYER_W_ELEMS;
        if ((l & 1) == 0) {
            tr_plain(p.in[1] + (size_t)j * DM * INC, INC, INC, DM, wl, INP, scr, lane, gw, NGW, base);
            tr_plain(p.in[7] + (size_t)j * DM * DM, DM, DM, DM, wl + OFF_WOUT, DM, scr, lane, gw, NGW, base);
        } else {
            tr_plain(p.in[8] + (size_t)j * DM * QKVN, QKVN, QKVN, DM, wl, QKVN, scr, lane, gw, NGW, base);
            tr_plain(p.in[10] + (size_t)j * DM * DM, DM, DM, DM, wl + OFF_WOUT, DM, scr, lane, gw, NGW, base);
        }
        tr_gu(p.in[15] + (size_t)l * DM * FF, p.in[16] + (size_t)l * DM * FF, wl + OFF_WGU, scr, lane, gw, NGW, base);
        tr_plain(p.in[17] + (size_t)l * FF * DM, DM, DM, FF, wl + OFF_WD, DM, scr, lane, gw, NGW, base);
    }
    const f32x4* x4 = (const f32x4*)p.in[0]; u32x2* hb2 = (u32x2*)(p.ws + WS_HB); u32x2* r2 = (u32x2*)((char*)p.out + (size_t)NTOK * DM * 2);
    const size_t n4 = (size_t)NTOK * DM / 4;
    const size_t stride = (size_t)gridDim.x * 512;
    for (size_t i = (size_t)blockIdx.x * 512 + tid; i < n4; i += 4 * stride) {
        f32x4 v[4];
#pragma unroll
        for (int q = 0; q < 4; ++q) v[q] = (i + q * stride < n4) ? x4[i + q * stride] : (f32x4){0.f, 0.f, 0.f, 0.f};
#pragma unroll
        for (int q = 0; q < 4; ++q) if (i + q * stride < n4) { u32x2 o; o.x = pk2(v[q][0], v[q][1]); o.y = pk2(v[q][2], v[q][3]); hb2[i + q * stride] = o; u32x2 r; r.x = pkh2(v[q][0], v[q][1]); r.y = pkh2(v[q][2], v[q][3]); r2[i + q * stride] = r; }
    }
}

__device__ __forceinline__ void ln_panel(const unsigned short* Y, float* OUT, bf16_t* HB, unsigned short* R16, const float* gam, const float* bet, int pm, const bool last, const int wv) {
    const int tid = tid_fresh(wv), wave = tid >> 6, lane = tid & 63;
    f32x4 gv[4], bv[4];
#pragma unroll
    for (int j = 0; j < 4; ++j) { gv[j] = ((const f32x4*)gam)[lane + 64 * j]; bv[j] = ((const f32x4*)bet)[lane + 64 * j]; }
#pragma unroll 1
    for (int rg = 0; rg < 4; ++rg) { const size_t row0 = (size_t)pm * 256 + wave * 32 + rg * 8;
        u32x2 raw[8][4];
#pragma unroll
        for (int q = 0; q < 8; ++q)
#pragma unroll
            for (int j = 0; j < 4; ++j) raw[q][j] = ((const u32x2*)(Y + (row0 + q) * DM))[lane + 64 * j];
#pragma unroll
        for (int q = 0; q < 8; ++q) {
            f32x4 v[4]; float s = 0.f;
#pragma unroll
            for (int j = 0; j < 4; ++j) { v[j] = (f32x4){h_lo(raw[q][j].x), h_hi(raw[q][j].x), h_lo(raw[q][j].y), h_hi(raw[q][j].y)}; s += (v[j][0] + v[j][1]) + (v[j][2] + v[j][3]); }
            const float mean = wave_sum(s) * (1.f / DM); float s2 = 0.f;
#pragma unroll
            for (int j = 0; j < 4; ++j) { v[j] = v[j] - mean; s2 += (v[j][0] * v[j][0] + v[j][1] * v[j][1]) + (v[j][2] * v[j][2] + v[j][3] * v[j][3]); }
            const float rstd = 1.0f / sqrtf(wave_sum(s2) * (1.f / DM) + LN_EPS);
            f32x4* xr = (f32x4*)(OUT + (row0 + q) * DM) + lane; u32x2* o8 = (u32x2*)(HB + (row0 + q) * DM) + lane; u32x2* r8 = (u32x2*)(R16 + (row0 + q) * DM) + lane;
#pragma unroll
            for (int j = 0; j < 4; ++j) { const f32x4 y = v[j] * rstd * gv[j] + bv[j];
                if (last) xr[64 * j] = y;
                else { u32x2 o; o.x = pk2(y[0], y[1]); o.y = pk2(y[2], y[3]); o8[64 * j] = o; u32x2 r; r.x = pkh2(y[0], y[1]); r.y = pkh2(y[2], y[3]); r8[64 * j] = r; } }
        }
    }
}
__device__ __forceinline__ void combine_range(const Params& p, int j, const int wv, const int first, const int end, const int tstride);
__device__ __forceinline__ void gemm_ln_phase(LAS unsigned char* lds, const bf16_t* A, const bf16_t* Bt, int K, unsigned short* Y, float* OUT, bf16_t* HB, unsigned short* R16, const float* gam, const float* bet, const bool last, const int wv, const Params& p, const int cmb) {
    for (int pm = blockIdx.x; pm < NPANEL; pm += gridDim.x) {
        if (cmb >= 0) {
            combine_range(p, cmb, wv, pm * 256, pm * 256 + 256, 8);
            __syncthreads();
            __builtin_amdgcn_fence(__ATOMIC_ACQUIRE, "agent");
            asm volatile("s_waitcnt vmcnt(0)" ::: "memory");
        }
        pg8::PanelOrder S; S.pm = pm; S.nN = 4;
        pg8::EpiResid E; E.Y = Y; E.R = last ? (const unsigned short*)HB : (const unsigned short*)R16; E.alpha = ALPHA; E.res_bf16 = last;
        pg8::Gemm g; g.A = A; g.Bt = Bt; g.M = NTOK; g.N = DM; g.K = K;
        pg8::gemm_phase(lds, g, S, E, wv);
        __syncthreads();
        ln_panel(Y, OUT, HB, R16, gam, bet, pm, last, wv);
        __syncthreads();
    }
}

__device__ __forceinline__ void conv_phase(const Params& p, int j, const int wv) {
    const bf16_t* proj = (const bf16_t*)(p.ws + WS_PROJ); bf16_t* mix = (bf16_t*)(p.ws + WS_MIX);
    const float* cw = p.in[4] + (size_t)j * 5 * DM;
    const size_t total = (size_t)NTOK * 128, stride = (size_t)gridDim.x * 512;
    const int tid = tid_fresh(wv);
    const int c = (tid & 127) * 8;
    f32x4 w0[5], w1[5];
#pragma unroll
    for (int jj = 0; jj < 5; ++jj) { w0[jj] = *(const f32x4*)(cw + jj * DM + c); w1[jj] = *(const f32x4*)(cw + jj * DM + c + 4); }
    const float sc = (c >= 512) ? 0.08838834764831845f : 1.0f;
    for (size_t idx = (size_t)blockIdx.x * 512 + tid; idx < total; idx += 2 * stride) {
        u32x4 xv[2][5];
#pragma unroll
        for (int q = 0; q < 2; ++q) { const size_t id = idx + q * stride; const int tok = (int)(id >> 7), t = tok & (SEQ - 1);
#pragma unroll
            for (int jj = 0; jj < 5; ++jj) { const int tt = t + jj - 2;
                xv[q][jj] = (id < total && tt >= 0 && tt < SEQ) ? *(const u32x4*)(proj + (size_t)(tok + jj - 2) * INP + C_BQ + c) : (u32x4){0u, 0u, 0u, 0u}; } }
#pragma unroll
        for (int q = 0; q < 2; ++q) { const size_t id = idx + q * stride; if (id >= total) break; const int tok = (int)(id >> 7);
            float a[8];
#pragma unroll
            for (int i = 0; i < 8; ++i) a[i] = 0.f;
#pragma unroll
            for (int jj = 0; jj < 5; ++jj) { const u32x4 x = xv[q][jj];
                a[0] += bf_lo(x.x) * w0[jj][0]; a[1] += bf_hi(x.x) * w0[jj][1]; a[2] += bf_lo(x.y) * w0[jj][2]; a[3] += bf_hi(x.y) * w0[jj][3];
                a[4] += bf_lo(x.z) * w1[jj][0]; a[5] += bf_hi(x.z) * w1[jj][1]; a[6] += bf_lo(x.w) * w1[jj][2]; a[7] += bf_hi(x.w) * w1[jj][3]; }
#pragma unroll
            for (int i = 0; i < 8; ++i) a[i] = siluf_(a[i]) * sc;
            u32x4 o; o.x = pk2(a[0], a[1]); o.y = pk2(a[2], a[3]); o.z = pk2(a[4], a[5]); o.w = pk2(a[6], a[7]);
            *(u32x4*)(mix + (size_t)tok * DM + c) = o; }
    }
}

template <bool ML>
__device__ __forceinline__ void chunk_scan(const Params& p, int j, int b, int h, int dir, LAS unsigned char* lds, const int wv) {
    constexpr int RS = 136, RT = 144, NCH = SEQ / 32;
    constexpr int BUF = (32 * RS * 2 + 32 * RT * 2) * 2 + 512;
    bf16_t* proj = (bf16_t*)(p.ws + WS_PROJ); const bf16_t* mix = (const bf16_t*)(p.ws + WS_MIX);
    const size_t rowbase = (size_t)b * SEQ;
    const int zc = (dir ? C_AFB : C_AFF) + h * 128;
    const int ocol = ML ? ((dir ? C_BK : C_BQ) + h * 128) : zc;
    if (wv >= 4) {
        const int gtid = tid_fresh(wv) - 256, dp = gtid >> 2, tq = gtid & 3, d = 2 * dp, vs_s = gtid >> 4, vs_c = (gtid & 15) * 8;
        float lb[2] = {0.f, 0.f}, oml[2] = {1.f, 1.f}, bi = 0.f, bff = 0.f;
        if (ML) { bi = p.in[2][j * 16 + dir * 4 + h]; bff = p.in[2][j * 16 + (2 + dir) * 4 + h]; }
        else if (j != 0) {
#pragma unroll
            for (int e = 0; e < 2; ++e) { const float r0 = p.in[3][dir * 1024 + h * 128 + d + e], r1 = p.in[3][dir * 1024 + 512 + h * 128 + d + e]; oml[e] = rcpf_(1.0f + __expf(r1 - r0)); lb[e] = 1.0f - oml[e]; } }
        unsigned pq[8], pg[8]; bf16_t pgi[8], pgf[8]; u32x4 pv0, pv1;
        const unsigned lrow = (unsigned)(dir ? (24 - tq * 8) : tq * 8), lrowv = (unsigned)(dir ? (15 - vs_s) : vs_s);
        const unsigned lq = ML ? (lrow * DM + h * 128 + d) * 2u : (lrow * INP + C_AQ + h * 128 + d) * 2u;
        const unsigned lg = ML ? (lrow * DM + 512 + h * 128 + d) * 2u : (lrow * INP + zc + d) * 2u;
        const unsigned lgi = (lrow * INP + C_BG + dir * 4 + h) * 2u, lgf = (lrow * INP + C_BG + (2 + dir) * 4 + h) * 2u;
        const unsigned lv = (lrowv * INP + (ML ? C_BV : C_AI) + h * 128 + vs_c) * 2u;
        const char* gproj = (const char*)proj; const char* gmix = (const char*)mix;
#define SCAN_LOAD(c) do { \
        _Pragma("unroll") for (int i = 0; i < 8; ++i) { const size_t urow = rowbase + (size_t)(dir ? (SEQ - 32 - (c) * 32 + 7 - i) : ((c) * 32 + i)); \
            if (ML) { pq[i] = *(const unsigned*)(gmix + urow * (DM * 2) + lq); pg[i] = *(const unsigned*)(gmix + urow * (DM * 2) + lg); \
                      pgi[i] = *(const bf16_t*)(gproj + urow * (INP * 2) + lgi); pgf[i] = *(const bf16_t*)(gproj + urow * (INP * 2) + lgf); } \
            else { pq[i] = *(const unsigned*)(gproj + urow * (INP * 2) + lq); pg[i] = *(const unsigned*)(gproj + urow * (INP * 2) + lg); } } \
        { const size_t u0 = rowbase + (size_t)(dir ? (SEQ - 32 - (c) * 32 + 16) : ((c) * 32)), u1 = rowbase + (size_t)(dir ? (SEQ - 32 - (c) * 32) : ((c) * 32 + 16)); \
          pv0 = *(const u32x4*)(gproj + u0 * (INP * 2) + lv); pv1 = *(const u32x4*)(gproj + u1 * (INP * 2) + lv); } } while (0)
        float kk[2][8], qv[2][8], liv[8], cs[2][8], run[2];
#define SCAN_GATE_A(c) do { \
        LAS bf16_t* Vs = (LAS bf16_t*)(lds + ((c) & 1) * BUF) + 64 * RS + 32 * RT; \
        *(LAS u32x4*)(Vs + vs_s * RT + vs_c) = pv0; *(LAS u32x4*)(Vs + (vs_s + 16) * RT + vs_c) = pv1; \
        run[0] = 0.f; run[1] = 0.f; \
        _Pragma("unroll") for (int i = 0; i < 8; ++i) { \
            float lfs = 0.f; \
            if (ML) { liv[i] = bf1(pgi[i]) + bi; const float x = bf1(pgf[i]) + bff; lfs = fminf(x, 0.f) - logf_(1.0f + __expf(-fabsf(x))); } else liv[i] = 0.f; \
            _Pragma("unroll") for (int e = 0; e < 2; ++e) { \
                qv[e][i] = e ? bf_hi(pq[i]) : bf_lo(pq[i]); const float gval = e ? bf_hi(pg[i]) : bf_lo(pg[i]); float lf; \
                if (ML) { kk[e][i] = gval; lf = lfs; } \
                else { const float z = gval; const float ex = __expf(-fabsf(z)), r = rcpf_(1.0f + ex); const float sg = (z >= 0.f) ? r : ex * r, sgm = (z >= 0.f) ? ex * r : r; \
                    kk[e][i] = oml[e] * sgm; \
                    lf = logf_(lb[e] + oml[e] * sg); } \
                run[e] += lf; cs[e][i] = run[e]; } } } while (0)
#define SCAN_GATE_B(c) do { \
        LAS bf16_t* Qh = (LAS bf16_t*)(lds + ((c) & 1) * BUF); LAS bf16_t* Kh = Qh + 32 * RS; LAS bf16_t* Kt = Kh + 32 * RS; LAS float* dl = (LAS float*)(Kt + 64 * RT); \
        float prefix[2], blast[2], edl[2]; \
        _Pragma("unroll") for (int e = 0; e < 2; ++e) { const float x1 = __shfl_xor(run[e], 1), x2 = __shfl_xor(run[e], 2), x3 = __shfl_xor(run[e], 3); \
            prefix[e] = (tq == 0) ? 0.f : (tq == 1) ? x1 : (tq == 2) ? (x2 + x3) : (x1 + x2 + x3); blast[e] = (run[e] + x1) + (x2 + x3); edl[e] = __expf(blast[e]); } \
        _Pragma("unroll") for (int i = 0; i < 8; ++i) { const int t = tq * 8 + i; float qh[2], kh[2], kt[2]; \
            _Pragma("unroll") for (int e = 0; e < 2; ++e) { const float bt = prefix[e] + cs[e][i]; \
                qh[e] = qv[e][i] * __expf(bt); kh[e] = kk[e][i] * __expf(liv[i] - bt); kt[e] = kh[e] * edl[e]; } \
            *(LAS unsigned*)(Qh + t * RS + d) = pk2(qh[0], qh[1]); *(LAS unsigned*)(Kh + t * RS + d) = pk2(kh[0], kh[1]); *(LAS unsigned*)(Kt + t * RT + d) = pk2(kt[0], kt[1]); } \
        if (tq == 0) { dl[d] = edl[0]; dl[d + 1] = edl[1]; } } while (0)
#define SCAN_BAR() asm volatile("s_waitcnt lgkmcnt(0)\n\ts_barrier" ::: "memory")
        SCAN_LOAD(0);
        SCAN_GATE_A(0);
        SCAN_LOAD(1);
        SCAN_GATE_B(0);
        SCAN_BAR();
#pragma unroll 1
        for (int c = 0; c < NCH; ++c) {
            if (c + 1 < NCH) { SCAN_GATE_A(c + 1); { const int cn = (c + 2 < NCH) ? (c + 2) : (NCH - 1); SCAN_LOAD(cn); } SCAN_GATE_B(c + 1); }
            SCAN_BAR();
        }
#undef SCAN_LOAD
#undef SCAN_GATE_A
#undef SCAN_GATE_B
#undef SCAN_BAR
    } else {
        const int tid = tid_fresh(wv), wave = wv, lane = tid & 63, li = lane & 15, quad = lane >> 4;
        f32x4 Macc[2][8], nacc[8];
#pragma unroll
        for (int i = 0; i < 8; ++i) { Macc[0][i] = (f32x4){0.f, 0.f, 0.f, 0.f}; Macc[1][i] = (f32x4){0.f, 0.f, 0.f, 0.f}; nacc[i] = (f32x4){0.f, 0.f, 0.f, 0.f}; }
        union { bf16x8 v; unsigned u[4]; } ones; ones.u[0] = ones.u[1] = ones.u[2] = ones.u[3] = 0x3F803F80u;
        asm volatile("s_waitcnt lgkmcnt(0)\n\ts_barrier" ::: "memory");
#pragma unroll 1
        for (int c = 0; c < NCH; ++c) {
            const LAS bf16_t* Qh = (const LAS bf16_t*)(lds + (c & 1) * BUF); const LAS bf16_t* Kh = Qh + 32 * RS; const LAS bf16_t* Kt = Kh + 32 * RS; const LAS bf16_t* Vs = Kt + 32 * RT; const LAS float* dl = (const LAS float*)(Vs + 32 * RT);
            f32x4 at00 = {0.f, 0.f, 0.f, 0.f}, at01 = at00, at11 = at00;
#pragma unroll
            for (int ks = 0; ks < 4; ++ks) {
                const bf16x8 kf0 = *(const LAS bf16x8*)(Kh + li * RS + ks * 32 + quad * 8), kf1 = *(const LAS bf16x8*)(Kh + (16 + li) * RS + ks * 32 + quad * 8);
                const bf16x8 qf0 = *(const LAS bf16x8*)(Qh + li * RS + ks * 32 + quad * 8), qf1 = *(const LAS bf16x8*)(Qh + (16 + li) * RS + ks * 32 + quad * 8);
                at00 = __builtin_amdgcn_mfma_f32_16x16x32_bf16(kf0, qf0, at00, 0, 0, 0);
                at01 = __builtin_amdgcn_mfma_f32_16x16x32_bf16(kf0, qf1, at01, 0, 0, 0);
                at11 = __builtin_amdgcn_mfma_f32_16x16x32_bf16(kf1, qf1, at11, 0, 0, 0);
            }
#pragma unroll
            for (int jj = 0; jj < 4; ++jj) { const bool keep = (quad * 4 + jj) <= li; at00[jj] = keep ? at00[jj] : 0.f; at11[jj] = keep ? at11[jj] : 0.f; }
            union { bf16x8 v; unsigned u[4]; } pb0, pb1;
            pb0.u[0] = pk2(at00[0], at00[1]); pb0.u[1] = pk2(at00[2], at00[3]); pb0.u[2] = 0u; pb0.u[3] = 0u;
            pb1.u[0] = pk2(at01[0], at01[1]); pb1.u[1] = pk2(at01[2], at01[3]); pb1.u[2] = pk2(at11[0], at11[1]); pb1.u[3] = pk2(at11[2], at11[3]);
            bf16x8 av[2]; f32x4 ot[2][2], den0 = {0.f, 0.f, 0.f, 0.f}, den1 = den0;
#pragma unroll
            for (int ct = 0; ct < 2; ++ct) { const int col0 = 32 * wave + 16 * ct;
                const s16x4 va0 = __builtin_amdgcn_ds_read_tr16_b64_v4i16((LAS s16x4*)(Vs + (quad * 4 + (li >> 2)) * RT + col0 + (li & 3) * 4));
                const s16x4 va1 = __builtin_amdgcn_ds_read_tr16_b64_v4i16((LAS s16x4*)(Vs + (16 + quad * 4 + (li >> 2)) * RT + col0 + (li & 3) * 4));
                av[ct] = (bf16x8){va0[0], va0[1], va0[2], va0[3], va1[0], va1[1], va1[2], va1[3]};
                ot[ct][0] = __builtin_amdgcn_mfma_f32_16x16x32_bf16(av[ct], pb0.v, (f32x4){0.f, 0.f, 0.f, 0.f}, 0, 0, 0);
                ot[ct][1] = __builtin_amdgcn_mfma_f32_16x16x32_bf16(av[ct], pb1.v, (f32x4){0.f, 0.f, 0.f, 0.f}, 0, 0, 0); }
            if (ML) { den0 = __builtin_amdgcn_mfma_f32_16x16x32_bf16(ones.v, pb0.v, den0, 0, 0, 0); den1 = __builtin_amdgcn_mfma_f32_16x16x32_bf16(ones.v, pb1.v, den1, 0, 0, 0); }
#pragma unroll
            for (int k2 = 0; k2 < 4; ++k2) {
                union { bf16x8 v; unsigned u[4]; u32x2 h2[2]; } am, an, q0, q1;
                q0.h2[0] = *(const LAS u32x2*)(Qh + li * RS + (2 * k2) * 16 + quad * 4); q0.h2[1] = *(const LAS u32x2*)(Qh + li * RS + (2 * k2 + 1) * 16 + quad * 4);
                q1.h2[0] = *(const LAS u32x2*)(Qh + (16 + li) * RS + (2 * k2) * 16 + quad * 4); q1.h2[1] = *(const LAS u32x2*)(Qh + (16 + li) * RS + (2 * k2 + 1) * 16 + quad * 4);
#pragma unroll
                for (int ct = 0; ct < 2; ++ct) {
                    am.u[0] = pk2(Macc[ct][2 * k2][0], Macc[ct][2 * k2][1]); am.u[1] = pk2(Macc[ct][2 * k2][2], Macc[ct][2 * k2][3]); am.u[2] = pk2(Macc[ct][2 * k2 + 1][0], Macc[ct][2 * k2 + 1][1]); am.u[3] = pk2(Macc[ct][2 * k2 + 1][2], Macc[ct][2 * k2 + 1][3]);
                    ot[ct][0] = __builtin_amdgcn_mfma_f32_16x16x32_bf16(am.v, q0.v, ot[ct][0], 0, 0, 0);
                    ot[ct][1] = __builtin_amdgcn_mfma_f32_16x16x32_bf16(am.v, q1.v, ot[ct][1], 0, 0, 0); }
                if (ML) {
                    an.u[0] = pk2(nacc[2 * k2][0], nacc[2 * k2][1]); an.u[1] = pk2(nacc[2 * k2][2], nacc[2 * k2][3]); an.u[2] = pk2(nacc[2 * k2 + 1][0], nacc[2 * k2 + 1][1]); an.u[3] = pk2(nacc[2 * k2 + 1][2], nacc[2 * k2 + 1][3]);
                    den0 = __builtin_amdgcn_mfma_f32_16x16x32_bf16(an.v, q0.v, den0, 0, 0, 0);
                    den1 = __builtin_amdgcn_mfma_f32_16x16x32_bf16(an.v, q1.v, den1, 0, 0, 0);
                }
            }
#pragma unroll
            for (int tt = 0; tt < 2; ++tt) { float inv = 1.0f;
                if (ML) { const f32x4 dn = tt ? den1 : den0; inv = rcpf_(fmaxf(fabsf(dn[0]), 1.0f)); }
                const int g = c * 32 + tt * 16 + li; const size_t row = rowbase + (dir ? (SEQ - 1 - g) : g);
#pragma unroll
                for (int ct = 0; ct < 2; ++ct) { const f32x4 o = ot[ct][tt] * inv; u32x2 w; w.x = pk2(o[0], o[1]); w.y = pk2(o[2], o[3]);
                    *(u32x2*)(proj + row * INP + ocol + 32 * wave + 16 * ct + quad * 4) = w; } }
#pragma unroll
            for (int rt = 0; rt < 8; ++rt) {
                const s16x4 k0 = __builtin_amdgcn_ds_read_tr16_b64_v4i16((LAS s16x4*)(Kt + (quad * 4 + (li >> 2)) * RT + rt * 16 + (li & 3) * 4));
                const s16x4 k1 = __builtin_amdgcn_ds_read_tr16_b64_v4i16((LAS s16x4*)(Kt + (16 + quad * 4 + (li >> 2)) * RT + rt * 16 + (li & 3) * 4));
                const bf16x8 ka = {k0[0], k0[1], k0[2], k0[3], k1[0], k1[1], k1[2], k1[3]};
                const f32x4 dlv = *(const LAS f32x4*)(dl + rt * 16 + quad * 4);
                Macc[0][rt] = __builtin_amdgcn_mfma_f32_16x16x32_bf16(ka, av[0], Macc[0][rt] * dlv, 0, 0, 0);
                Macc[1][rt] = __builtin_amdgcn_mfma_f32_16x16x32_bf16(ka, av[1], Macc[1][rt] * dlv, 0, 0, 0);
                if (ML) nacc[rt] = __builtin_amdgcn_mfma_f32_16x16x32_bf16(ka, ones.v, nacc[rt] * dlv, 0, 0, 0);
            }
            asm volatile("s_waitcnt lgkmcnt(0)\n\ts_barrier" ::: "memory");
        }
    }
    __syncthreads();
}
__device__ __forceinline__ void scan_phase(const Params& p, int j, LAS unsigned char* lds, const int wv) {
    for (int chain = blockIdx.x; chain < 256; chain += gridDim.x) {
        const int type = chain >> 7, rem = chain & 127, dir = rem & 1, h = (rem >> 1) & 3, b = rem >> 3;
        if (type == 0) chunk_scan<false>(p, j, b, h, dir, lds, wv); else chunk_scan<true>(p, j, b, h, dir, lds, wv);
    }
}

__device__ __forceinline__ void combine_range(const Params& p, int j, const int wv, const int first, const int end, const int tstride) {
    const bf16_t* proj = (const bf16_t*)(p.ws + WS_PROJ); bf16_t* mix = (bf16_t*)(p.ws + WS_MIX);
    const int tid = tid_fresh(wv), wave = tid >> 6, lane = tid & 63;
    const int isB = lane >> 5, cc = (lane & 31) * 16;
    const int c1 = isB ? C_BQ : C_AFF, c2 = isB ? C_BK : C_AFB, c3 = isB ? C_BO : C_AG;
    const float* gn = (isB ? p.in[6] : p.in[5]) + (size_t)j * 512 + cc;
    float gnv[16];
#pragma unroll
    for (int i = 0; i < 16; ++i) gnv[i] = gn[i];
    for (int tok0 = first + wave; tok0 < end; tok0 += 2 * tstride) {
        u32x4 x1a[2], x1b[2], x2a[2], x2b[2], ga[2], gb[2];
#pragma unroll
        for (int q = 0; q < 2; ++q) { const int tok = min(tok0 + q * tstride, end - 1); const bf16_t* rp = proj + (size_t)tok * INP;
            x1a[q] = *(const u32x4*)(rp + c1 + cc); x1b[q] = *(const u32x4*)(rp + c1 + cc + 8);
            x2a[q] = *(const u32x4*)(rp + c2 + cc); x2b[q] = *(const u32x4*)(rp + c2 + cc + 8);
            ga[q] = *(const u32x4*)(rp + c3 + cc); gb[q] = *(const u32x4*)(rp + c3 + cc + 8); }
#pragma unroll
        for (int q = 0; q < 2; ++q) { const int tok = tok0 + q * tstride;
            float s[16], g[16];
            const unsigned x1w[8] = {x1a[q].x, x1a[q].y, x1a[q].z, x1a[q].w, x1b[q].x, x1b[q].y, x1b[q].z, x1b[q].w};
            const unsigned x2w[8] = {x2a[q].x, x2a[q].y, x2a[q].z, x2a[q].w, x2b[q].x, x2b[q].y, x2b[q].z, x2b[q].w};
            const unsigned gw[8] = {ga[q].x, ga[q].y, ga[q].z, ga[q].w, gb[q].x, gb[q].y, gb[q].z, gb[q].w};
#pragma unroll
            for (int i = 0; i < 8; ++i) { s[2 * i] = bf_lo(x1w[i]) + bf_lo(x2w[i]); s[2 * i + 1] = bf_hi(x1w[i]) + bf_hi(x2w[i]); g[2 * i] = bf_lo(gw[i]); g[2 * i + 1] = bf_hi(gw[i]); }
            float sum = 0.f;
#pragma unroll
            for (int i = 0; i < 16; ++i) sum += s[i];
            sum += __shfl_xor(sum, 1); sum += __shfl_xor(sum, 2); sum += __shfl_xor(sum, 4);
            const float mu = isB ? sum * (1.f / 128.f) : 0.f;
            float sq = 0.f;
#pragma unroll
            for (int i = 0; i < 16; ++i) { s[i] -= mu; sq += s[i] * s[i]; }
            sq += __shfl_xor(sq, 1); sq += __shfl_xor(sq, 2); sq += __shfl_xor(sq, 4);
            const float rs = __builtin_amdgcn_rsqf(sq * (1.f / 128.f) + GN_EPS);
            float o[16];
#pragma unroll
            for (int i = 0; i < 16; ++i) { const float act = isB ? sigmoidf_(g[i]) : siluf_(g[i]); o[i] = s[i] * rs * gnv[i] * act; }
            u32x4 oa, ob; oa.x = pk2(o[0], o[1]); oa.y = pk2(o[2], o[3]); oa.z = pk2(o[4], o[5]); oa.w = pk2(o[6], o[7]);
            ob.x = pk2(o[8], o[9]); ob.y = pk2(o[10], o[11]); ob.z = pk2(o[12], o[13]); ob.w = pk2(o[14], o[15]);
            if (tok < end) { bf16_t* op = mix + (size_t)tok * DM + isB * 512 + cc; *(u32x4*)op = oa; *(u32x4*)(op + 8) = ob; }
        }
    }
}

__device__ __forceinline__ void na_phase(const Params& p, int j, LAS unsigned char* lds, const int wv) {
    const char* gq = (const char*)(p.ws + WS_PROJ); char* gm = (char*)(p.ws + WS_MIX);
    const float* rpb = p.in[9] + (size_t)j * 32 * 15 * 31;
    const int wave = wv;
    LAS bf16_t* Vs = (LAS bf16_t*)(lds + wave * 16384);
    const int NGW = gridDim.x * 8;
    constexpr size_t TOKB = (size_t)QKVN * 2;
    for (int gw = blockIdx.x * 8 + wave; gw < 2048; gw += NGW) {
        int lane = (int)__builtin_amdgcn_mbcnt_hi(~0u, __builtin_amdgcn_mbcnt_lo(~0u, 0u)); asm volatile("" : "+v"(lane));
        const int li = lane & 15, quad = lane >> 4;
        const int combo = gw & 127, head = combo >> 2, n = combo & 3, b = gw >> 7;
        const int band0 = (n == 0) ? 0 : (n == 1) ? 8 : (n == 2) ? 24 : 32;
        const int qc = n * 16 + li, c0q = min(max(qc - 8, 0), 48);
        const unsigned klane = (unsigned)((li * QKVN + DM + head * 32 + quad * 8) * 2);
        const unsigned vlane = (unsigned)(((lane >> 2) * QKVN + 2 * DM + head * 32 + (lane & 3) * 8) * 2);
        const size_t qadj = (size_t)n * 16 * TOKB - (size_t)DM * 2;
        const unsigned olane = (unsigned)((qc * DM + head * 32 + quad * 4) * 2);
        int cur_dr = 99;
        unsigned biasp[16][2];
#pragma unroll
        for (int t = 0; t < 16; ++t) { biasp[t][0] = 0u; biasp[t][1] = 0u; }
        bf16x8 qf, kf[16];
        { const size_t bt0 = (size_t)b * SEQ + band0;
          qf = *(const bf16x8*)((uintptr_t)gq + ((size_t)b * SEQ * TOKB + qadj) + klane);
#pragma unroll
          for (int t = 0; t < 16; ++t) kf[t] = *(const bf16x8*)(gq + (bt0 + (t >> 1) * 64 + (t & 1) * 16) * TOKB + klane);
#pragma unroll
          for (int it = 0; it < 16; ++it)
              __builtin_amdgcn_global_load_lds((const unsigned*)(gq + (bt0 + (it >> 1) * 64 + (it & 1) * 16) * TOKB + vlane), (LAS unsigned*)(Vs + it * 512), 16, 0, 0); }
        int rot = 0;
#pragma unroll 1
        for (int r = 0; r < 64; ++r) {
            const int r0 = min(max(r - 4, 0), 56), dr = r0 - r;
            if (dr != cur_dr) {
#pragma unroll
                for (int t = 0; t < 16; ++t) { float bv[4];
#pragma unroll
                    for (int jj = 0; jj < 4; ++jj) { const int kc = band0 + (t & 1) * 16 + quad * 4 + jj; const bool valid = (kc >= c0q) && (kc < c0q + 16);
                        const int ri = dr + (t >> 1) + 7, ci = kc - qc + 15;
                        bv[jj] = valid ? rpb[(head * 15 + ri) * 31 + ci] : -1e30f; }
                    biasp[t][0] = pk2(bv[0], bv[1]); biasp[t][1] = pk2(bv[2], bv[3]);
                    if ((t & 3) == 3) __builtin_amdgcn_sched_barrier(0); }
                cur_dr = dr;
            }
            const size_t rowtok = (size_t)b * SEQ + (size_t)r * 64;
            const bool has_next = (r + 1 < 64);
            const bool slide = has_next && (min(max(r + 1 - 4, 0), 56) != r0);
            const size_t new_tok = (size_t)b * SEQ + (size_t)(r0 + 8) * 64 + band0;
            f32x4 st[16];
#pragma unroll
            for (int t = 0; t < 16; ++t) st[t] = __builtin_amdgcn_mfma_f32_16x16x32_bf16(kf[t], qf, (f32x4){0.f, 0.f, 0.f, 0.f}, 0, 0, 0);
            if (has_next) qf = *(const bf16x8*)((uintptr_t)gq + ((rowtok + 64) * TOKB + qadj) + klane);
            if (slide) {
#pragma unroll
                for (int t = 0; t < 14; ++t) kf[t] = kf[t + 2];
                kf[14] = *(const bf16x8*)(gq + new_tok * TOKB + klane);
                kf[15] = *(const bf16x8*)(gq + (new_tok + 16) * TOKB + klane);
            }
            float mx = -3e38f;
#pragma unroll
            for (int t = 0; t < 16; ++t)
#pragma unroll
                for (int jj = 0; jj < 4; ++jj) { const unsigned bw = biasp[t][jj >> 1]; const float bb = (jj & 1) ? bf_hi(bw) : bf_lo(bw); st[t][jj] = fmaf(st[t][jj], 0.17677669529663687f, bb); mx = fmaxf(mx, st[t][jj]); }
            mx = fmaxf(mx, __shfl_xor(mx, 16)); mx = fmaxf(mx, __shfl_xor(mx, 32));
            float l = 0.f;
#pragma unroll
            for (int t = 0; t < 16; ++t)
#pragma unroll
                for (int jj = 0; jj < 4; ++jj) { const float pj = __expf(st[t][jj] - mx); st[t][jj] = pj; l += pj; }
            l += __shfl_xor(l, 16); l += __shfl_xor(l, 32);
            if (slide) asm volatile("s_waitcnt vmcnt(3)" ::: "memory"); else if (has_next) asm volatile("s_waitcnt vmcnt(1)" ::: "memory"); else asm volatile("s_waitcnt vmcnt(0)" ::: "memory");
            f32x4 ot[2] = {(f32x4){0.f, 0.f, 0.f, 0.f}, (f32x4){0.f, 0.f, 0.f, 0.f}};
#pragma unroll
            for (int ks = 0; ks < 8; ++ks) {
                union { bf16x8 v; unsigned u[4]; } pb;
                pb.u[0] = pk2(st[2 * ks][0], st[2 * ks][1]); pb.u[1] = pk2(st[2 * ks][2], st[2 * ks][3]);
                pb.u[2] = pk2(st[2 * ks + 1][0], st[2 * ks + 1][1]); pb.u[3] = pk2(st[2 * ks + 1][2], st[2 * ks + 1][3]);
                const int slot = (ks + rot) & 7;
                const LAS bf16_t* vrow = Vs + (slot * 32 + quad * 4 + (li >> 2)) * 32 + (li & 3) * 4;
#pragma unroll
                for (int mt = 0; mt < 2; ++mt) {
                    const s16x4 a0 = __builtin_amdgcn_ds_read_tr16_b64_v4i16((LAS s16x4*)(vrow + mt * 16));
                    const s16x4 a1 = __builtin_amdgcn_ds_read_tr16_b64_v4i16((LAS s16x4*)(vrow + 16 * 32 + mt * 16));
                    const bf16x8 av = {a0[0], a0[1], a0[2], a0[3], a1[0], a1[1], a1[2], a1[3]};
                    ot[mt] = __builtin_amdgcn_mfma_f32_16x16x32_bf16(av, pb.v, ot[mt], 0, 0, 0);
                }
                if (ks & 1) __builtin_amdgcn_sched_barrier(0);
            }
            asm volatile("s_waitcnt lgkmcnt(0)" ::: "memory");
            const float inv = rcpf_(l);
#pragma unroll
            for (int mt = 0; mt < 2; ++mt) { u32x2 w; w.x = pk2(ot[mt][0] * inv, ot[mt][1] * inv); w.y = pk2(ot[mt][2] * inv, ot[mt][3] * inv);
                *(u32x2*)(gm + rowtok * (DM * 2) + olane + mt * 32) = w; }
            if (slide) {
#pragma unroll
                for (int hf = 0; hf < 2; ++hf)
                    __builtin_amdgcn_global_load_lds((const unsigned*)(gq + (new_tok + hf * 16) * TOKB + vlane), (LAS unsigned*)(Vs + (rot * 2 + hf) * 512), 16, 0, 0);
                rot = (rot + 1) & 7;
            }
        }
        asm volatile("s_waitcnt vmcnt(0)" ::: "memory");
    }
}

#define XB_TMO      128
#define XB_XCNT(j)  (256  + 64 * (j))
#define XB_XSUB(j)  (1280 + 64 * (j))
#define XB_XGEN(j)  (2304 + 64 * (j))
#define XB_TOP      3328
#define XB_TOPGEN   3392
#define XCD_BAR_WORDS 3456
#define XB_SPIN_CAP (1u << 18)
__device__ __forceinline__ unsigned xb_ld(unsigned* p)              { return __hip_atomic_load(p, __ATOMIC_RELAXED, __HIP_MEMORY_SCOPE_AGENT); }
__device__ __forceinline__ unsigned xb_add(unsigned* p, unsigned v) { return __hip_atomic_fetch_add(p, v, __ATOMIC_RELAXED, __HIP_MEMORY_SCOPE_AGENT); }
__device__ __forceinline__ unsigned xb_xcc_id() { return (unsigned)__builtin_amdgcn_s_getreg((3 << 11) | 20) & 0xFu; }
#define XB_SPIN(cond, bar) do { unsigned _sp = 0; while (cond) { __builtin_amdgcn_s_sleep(1); \
    if ((++_sp & 255u) == 0u) { if (xb_ld(&(bar)[XB_TMO])) break; if (_sp > XB_SPIN_CAP) { atomicAdd(&(bar)[XB_TMO], 1u); break; } } } } while (0)
struct XcdBarrier { unsigned* bar; unsigned x; volatile LAS unsigned* st; int wv; };
__device__ __forceinline__ XcdBarrier xcd_barrier_post(unsigned* bar, volatile LAS unsigned* st, const int wv) {
    XcdBarrier b; b.bar = bar; b.x = xb_xcc_id(); b.st = st; b.wv = wv;
    if (wv == 0 && lane_id() == 0) (void)xb_add(&bar[XB_XCNT(b.x)], 1u);
    return b;
}
__device__ __forceinline__ void xcd_barrier_complete(unsigned* bar, unsigned x, unsigned& nloc, unsigned& nx) {
    const unsigned G = gridDim.x * gridDim.y * gridDim.z;
    unsigned sum, cnt, mine, sp = 0u;
    for (;;) {
        sum = 0u; cnt = 0u; mine = 0u;
#pragma unroll
        for (unsigned j = 0; j < 16; ++j) { const unsigned c = xb_ld(&bar[XB_XCNT(j)]); sum += c; cnt += (c > 0u) ? 1u : 0u; mine = (j == x) ? c : mine; }
        if (sum == G) break;
        __builtin_amdgcn_s_sleep(1);
        if ((++sp & 255u) == 0u) { if (xb_ld(&bar[XB_TMO])) break; if (sp > XB_SPIN_CAP) { atomicAdd(&bar[XB_TMO], 1u); break; } }
    }
    nloc = mine > 0u ? mine : 1u; nx = cnt > 0u ? cnt : 1u;
}
__device__ __forceinline__ void xcd_barrier(const XcdBarrier& b) {
    asm volatile("s_waitcnt vmcnt(0)" ::: "memory");
    __syncthreads();
    if (b.wv == 0 && lane_id() == 0) {
        unsigned* bar = b.bar;
        __builtin_amdgcn_s_waitcnt(0);
        unsigned nloc = b.st[0], nx = b.st[1];
        if (nloc == 0u) { xcd_barrier_complete(bar, b.x, nloc, nx); b.st[0] = nloc; b.st[1] = nx; }
        const unsigned old = xb_add(&bar[XB_XSUB(b.x)], 1u);
        const unsigned gen = old / nloc;
        if (old + 1u == (gen + 1u) * nloc) {
            __builtin_amdgcn_fence(__ATOMIC_RELEASE, "agent");
            asm volatile("s_waitcnt vmcnt(0)" ::: "memory");
            const unsigned og = xb_add(&bar[XB_TOP], 1u);
            const unsigned tg = og / nx;
            if (og + 1u == (tg + 1u) * nx) xb_add(&bar[XB_TOPGEN], 1u);
            else XB_SPIN(xb_ld(&bar[XB_TOPGEN]) == tg, bar);
            __builtin_amdgcn_fence(__ATOMIC_ACQUIRE, "agent");
            xb_add(&bar[XB_XGEN(b.x)], 1u);
            asm volatile("s_waitcnt vmcnt(0)" ::: "memory");
        } else {
            XB_SPIN(xb_ld(&bar[XB_XGEN(b.x)]) == gen, bar);
            __builtin_amdgcn_fence(__ATOMIC_ACQUIRE, "agent");
            asm volatile("s_waitcnt vmcnt(0)" ::: "memory");
        }
    }
    __syncthreads();
}

__global__ void __launch_bounds__(512, 2) mega_fwd(Params p) {
    extern __shared__ __attribute__((aligned(16))) unsigned char shm[];
    LAS unsigned char* lds = (LAS unsigned char*)shm;
    cg::grid_group grid = cg::this_grid();
    bf16_t* WT = (bf16_t*)(p.ws + WS_WT); bf16_t* HB = (bf16_t*)(p.ws + WS_HB); bf16_t* PROJ = (bf16_t*)(p.ws + WS_PROJ); bf16_t* MIX = (bf16_t*)(p.ws + WS_MIX);
    unsigned short* R16 = (unsigned short*)((char*)p.out + (size_t)NTOK * DM * 2);
    const int wv = __builtin_amdgcn_readfirstlane((int)(threadIdx.x >> 6));
    volatile LAS unsigned* xbst = (volatile LAS unsigned*)(lds + 131072);
    if (wv == 0 && lane_id() == 0) { xbst[0] = 0u; xbst[1] = 0u; xbst[2] = 0u; xbst[3] = 0u; }
    __syncthreads();
    const XcdBarrier xb = xcd_barrier_post((unsigned*)(p.ws + WS_BAR), xbst, wv);
    p0_phase(p, lds, wv);
    grid.sync();
    for (int l = 0; l < 4; ++l) {
        const int j = l >> 1; const bool even = (l & 1) == 0; const bf16_t* wl = WT + (size_t)l * LAYER_W_ELEMS;
        {
            const int N = even ? INP : QKVN;
            pg8::StaticOrder S; S.init(NTOK, N, (int)gridDim.x, (int)blockIdx.x);
            pg8::EpiStoreBf16 E; E.O = PROJ; E.ldc = N;
            pg8::Gemm g; g.A = HB; g.Bt = wl; g.M = NTOK; g.N = N; g.K = DM;
            pg8::gemm_phase(lds, g, S, E, wv);
        }
        xcd_barrier(xb);
        if (even) {
            conv_phase(p, j, wv);
            xcd_barrier(xb);
            scan_phase(p, j, lds, wv);
            xcd_barrier(xb);
        } else {
            na_phase(p, j, lds, wv);
            xcd_barrier(xb);
        }
        gemm_ln_phase(lds, MIX, wl + OFF_WOUT, DM, (unsigned short*)p.out, p.out, HB, R16, p.in[11] + l * DM, p.in[12] + l * DM, false, wv, p, even ? j : -1);
        xcd_barrier(xb);
        {
            pg8::StaticOrder S; S.init(NTOK, GUN, (int)gridDim.x, (int)blockIdx.x);
            pg8::EpiSwiglu E; E.O = PROJ; E.ldc = FF;
            pg8::Gemm g; g.A = HB; g.Bt = wl + OFF_WGU; g.M = NTOK; g.N = GUN; g.K = DM;
            pg8::gemm_phase(lds, g, S, E, wv);
        }
        xcd_barrier(xb);
        gemm_ln_phase(lds, PROJ, wl + OFF_WD, FF, (unsigned short*)MIX, p.out, HB, R16, p.in[13] + l * DM, p.in[14] + l * DM, l == 3, wv, p, -1);
        xcd_barrier(xb);
    }
}

extern "C" void kernel_launch(void* const* d_in, const int* in_sizes, int n_in, void* d_out, int out_size, void* d_ws, size_t ws_size, hipStream_t stream) {
    static int grid_blocks = 0;
    if (grid_blocks == 0) {
        if (n_in != 18 || out_size != NTOK * DM || ws_size < WS_TOTAL) { fprintf(stderr, "kernel_launch: unexpected problem (n_in %d out %d ws %zu need %zu)\n", n_in, out_size, ws_size, (size_t)WS_TOTAL); grid_blocks = -1; return; }
        int dev = 0, cus = 0, per_cu = 0;
        hipGetDevice(&dev);
        hipDeviceGetAttribute(&cus, hipDeviceAttributeMultiprocessorCount, dev);
        if (hipFuncSetAttribute((const void*)mega_fwd, hipFuncAttributeMaxDynamicSharedMemorySize, LDS_BYTES) != hipSuccess) { fprintf(stderr, "kernel_launch: hipFuncSetAttribute failed\n"); }
        if (hipOccupancyMaxActiveBlocksPerMultiprocessor(&per_cu, (const void*)mega_fwd, 512, LDS_BYTES) != hipSuccess || per_cu < 1) { fprintf(stderr, "kernel_launch: occupancy query gives %d\n", per_cu); per_cu = 1; }
        (void)hipGetLastError();
        grid_blocks = cus * per_cu;
    }
    if (grid_blocks < 0) return;
    if (hipMemsetAsync((char*)d_ws + WS_BAR, 0, XCD_BAR_WORDS * 4, stream) != hipSuccess) { fprintf(stderr, "kernel_launch: memset of barrier words failed\n"); return; }
    Params p{};
    for (int i = 0; i < 18; ++i) p.in[i] = (const float*)d_in[i];
    p.out = (float*)d_out; p.ws = (unsigned char*)d_ws;
    void* args[] = {&p};
    hipError_t e = hipLaunchCooperativeKernel((const void*)mega_fwd, dim3(grid_blocks), dim3(512), args, LDS_BYTES, stream);
    if (e != hipSuccess) fprintf(stderr, "cooperative launch failed: %s (grid %d)\n", hipGetErrorString(e), grid_blocks);
}
```
